# Optimizing an MI355X kernel written in HIP

```python
import jax, jax.numpy as jnp
from jax import lax
import numpy as np

D_MODEL = 1024
BATCH = 8
SEQ = 4096
DEPTH = 2

N_A = DEPTH // 2
N_B = DEPTH - N_A
PLE_DIM = 256
FOX_HEADS = 16
FOX_HEAD_DIM = D_MODEL // FOX_HEADS
FOX_IN = 3 * D_MODEL + FOX_HEADS
FOX_GATE_BIAS = 3.0
MLA_HEADS = 16
QK_NOPE_DIM = 128
QK_ROPE_DIM = 64
V_HEAD_DIM = 128
Q_LORA_RANK = 384
KV_LORA_RANK = 256
ROPE_THETA = 10000.0
D_FF = 2816
BLOCK_Q = 128
LN_EPS = 1e-5
RMS_EPS = 1e-6
ALPHA = (2 * DEPTH) ** 0.25
BETA = (8 * DEPTH) ** -0.25

kernel_name = 'yoco_fox_mla_macaron_deepnorm'


def layer_norm(x, g, b):
    xf = x.astype(jnp.float32)
    mu = jnp.mean(xf, axis=-1, keepdims=True)
    xc = xf - mu
    var = jnp.mean(xc * xc, axis=-1, keepdims=True)
    y = xc * lax.rsqrt(var + LN_EPS) * g.astype(jnp.float32) + b.astype(jnp.float32)
    return y.astype(x.dtype)


def rms_norm(x, g):
    xf = x.astype(jnp.float32)
    y = xf * lax.rsqrt(jnp.mean(xf * xf, axis=-1, keepdims=True) + RMS_EPS) * g.astype(jnp.float32)
    return y.astype(x.dtype)


def post_norm(x, delta, g, b):
    return layer_norm(ALPHA * x + delta, g, b)


def swiglu(x, w_in, w_out):
    h = x @ w_in
    gate, up = h[..., :D_FF], h[..., D_FF:]
    return (jax.nn.silu(gate) * up) @ w_out


def rope_tables(seq_len):
    half = QK_ROPE_DIM // 2
    inv = ROPE_THETA ** (-jnp.arange(half, dtype=jnp.float32) * (2.0 / QK_ROPE_DIM))
    ang = jnp.arange(seq_len, dtype=jnp.float32)[:, None] * inv[None, :]
    return jnp.cos(ang), jnp.sin(ang)


def rope(x, cos, sin):
    half = x.shape[-1] // 2
    xf = x.astype(jnp.float32)
    x1, x2 = xf[..., :half], xf[..., half:]
    return jnp.concatenate([x1 * cos - x2 * sin, x2 * cos + x1 * sin], axis=-1).astype(x.dtype)


def causal_block_attention(score_fn, v):
    B, S, H, Dv = v.shape
    n_blocks = S // BLOCK_Q
    k_pos = jnp.arange(S)

    def one_block(blk):
        start = blk * BLOCK_Q
        s = score_fn(start)
        q_pos = start + jnp.arange(BLOCK_Q)
        s = jnp.where(k_pos[None, :] <= q_pos[:, None], s, -jnp.inf)
        w = jax.nn.softmax(s, axis=-1).astype(v.dtype)
        return jnp.einsum('bhqk,bkhd->bqhd', w, v)

    o = lax.map(one_block, jnp.arange(n_blocks))
    return jnp.moveaxis(o, 0, 1).reshape(B, S, H, Dv)


def fox_mixer(x, w_in, b_f, w_o):
    B, S, _ = x.shape
    h = x @ w_in
    q = h[..., :D_MODEL].reshape(B, S, FOX_HEADS, FOX_HEAD_DIM)
    k = h[..., D_MODEL:2 * D_MODEL].reshape(B, S, FOX_HEADS, FOX_HEAD_DIM)
    v = h[..., 2 * D_MODEL:3 * D_MODEL].reshape(B, S, FOX_HEADS, FOX_HEAD_DIM)
    f_logit = h[..., 3 * D_MODEL:].astype(jnp.float32) + b_f.astype(jnp.float32)
    cum = jnp.cumsum(jax.nn.log_sigmoid(f_logit), axis=1).transpose(0, 2, 1)
    scale = FOX_HEAD_DIM ** -0.5

    def scores(start):
        qb = lax.dynamic_slice_in_dim(q, start, BLOCK_Q, axis=1)
        cb = lax.dynamic_slice_in_dim(cum, start, BLOCK_Q, axis=2)
        s = jnp.einsum('bqhd,bkhd->bhqk', qb, k).astype(jnp.float32) * scale
        return s + cb[:, :, :, None] - cum[:, :, None, :]

    o = causal_block_attention(scores, v)
    return o.reshape(B, S, D_MODEL) @ w_o


def shared_kv(x, w_down, kv_norm, w_up, cos, sin):
    B, S, _ = x.shape
    h = x @ w_down
    c_kv = rms_norm(h[..., :KV_LORA_RANK], kv_norm)
    k_rope = rope(h[..., KV_LORA_RANK:], cos, sin)
    kv = jnp.einsum('bsc,chd->bshd', c_kv, w_up)
    return kv[..., :QK_NOPE_DIM], k_rope, kv[..., QK_NOPE_DIM:]


def mla_mixer(x, w_dq, q_norm, w_uq, w_o, k_nope, k_rope, v, cos, sin):
    B, S, _ = x.shape
    c_q = rms_norm(x @ w_dq, q_norm)
    q = jnp.einsum('bsc,chd->bshd', c_q, w_uq)
    q_nope = q[..., :QK_NOPE_DIM]
    q_rope = rope(q[..., QK_NOPE_DIM:], cos[:, None, :], sin[:, None, :])
    scale = (QK_NOPE_DIM + QK_ROPE_DIM) ** -0.5

    def scores(start):
        qn = lax.dynamic_slice_in_dim(q_nope, start, BLOCK_Q, axis=1)
        qr = lax.dynamic_slice_in_dim(q_rope, start, BLOCK_Q, axis=1)
        s = jnp.einsum('bqhd,bkhd->bhqk', qn, k_nope) + jnp.einsum('bqhr,bkr->bhqk', qr, k_rope)
        return s.astype(jnp.float32) * scale

    o = causal_block_attention(scores, v)
    return o.reshape(B, S, MLA_HEADS * V_HEAD_DIM) @ w_o


def setup_inputs(seed: int = 0) -> dict:
    key = jax.random.key(seed)
    ks = iter(jax.random.split(key, 32))
    f32 = jnp.float32

    def nrm(shape, fan_in, scale=1.0):
        return jax.random.normal(next(ks), shape, f32) * (scale * fan_in ** -0.5)

    def gain(shape):
        return 1.0 + 0.02 * jax.random.normal(next(ks), shape, f32)

    def small(shape, s=0.02):
        return s * jax.random.normal(next(ks), shape, f32)

    x = jax.random.normal(next(ks), (BATCH, SEQ, D_MODEL), f32)
    p = jax.random.normal(next(ks), (DEPTH, BATCH, SEQ, PLE_DIM), f32)
    ffn1_w_in = nrm((DEPTH, D_MODEL, 2 * D_FF), D_MODEL)
    ffn1_w_out = nrm((DEPTH, D_FF, D_MODEL), D_FF, BETA)
    ffn2_w_in = nrm((DEPTH, D_MODEL, 2 * D_FF), D_MODEL)
    ffn2_w_out = nrm((DEPTH, D_FF, D_MODEL), D_FF, BETA)
    ln_g = gain((DEPTH, 4, D_MODEL))
    ln_b = small((DEPTH, 4, D_MODEL))
    ple_w_gate = nrm((DEPTH, D_MODEL, D_MODEL), D_MODEL)
    ple_b_gate = small((DEPTH, D_MODEL))
    ple_w_proj = nrm((DEPTH, PLE_DIM, D_MODEL), PLE_DIM, BETA)
    fox_w_in = nrm((N_A, D_MODEL, FOX_IN), D_MODEL)
    fox_w_in = fox_w_in.at[:, :, 2 * D_MODEL:3 * D_MODEL].multiply(BETA)
    fox_b_f = FOX_GATE_BIAS + 0.5 * jax.random.normal(next(ks), (N_A, FOX_HEADS), f32)
    fox_w_o = nrm((N_A, D_MODEL, D_MODEL), D_MODEL, BETA)
    mla_w_dq = nrm((N_B, D_MODEL, Q_LORA_RANK), D_MODEL)
    mla_q_norm = gain((N_B, Q_LORA_RANK))
    mla_w_uq = nrm((N_B, Q_LORA_RANK, MLA_HEADS, QK_NOPE_DIM + QK_ROPE_DIM), Q_LORA_RANK)
    mla_w_o = nrm((N_B, MLA_HEADS * V_HEAD_DIM, D_MODEL), MLA_HEADS * V_HEAD_DIM, BETA)
    kv_w_down = nrm((D_MODEL, KV_LORA_RANK + QK_ROPE_DIM), D_MODEL)
    kv_norm = gain((KV_LORA_RANK,))
    kv_w_up = nrm((KV_LORA_RANK, MLA_HEADS, QK_NOPE_DIM + V_HEAD_DIM), KV_LORA_RANK)
    kv_w_up = kv_w_up.at[:, :, QK_NOPE_DIM:].multiply(BETA)
    return {'x': x, 'p': p,
            'ffn1_w_in': ffn1_w_in, 'ffn1_w_out': ffn1_w_out,
            'ffn2_w_in': ffn2_w_in, 'ffn2_w_out': ffn2_w_out,
            'ln_g': ln_g, 'ln_b': ln_b,
            'ple_w_gate': ple_w_gate, 'ple_b_gate': ple_b_gate, 'ple_w_proj': ple_w_proj,
            'fox_w_in': fox_w_in, 'fox_b_f': fox_b_f, 'fox_w_o': fox_w_o,
            'mla_w_dq': mla_w_dq, 'mla_q_norm': mla_q_norm, 'mla_w_uq': mla_w_uq, 'mla_w_o': mla_w_o,
            'kv_w_down': kv_w_down, 'kv_norm': kv_norm, 'kv_w_up': kv_w_up}


def reference(x, p, ffn1_w_in, ffn1_w_out, ffn2_w_in, ffn2_w_out, ln_g, ln_b,
              ple_w_gate, ple_b_gate, ple_w_proj, fox_w_in, fox_b_f, fox_w_o,
              mla_w_dq, mla_q_norm, mla_w_uq, mla_w_o, kv_w_down, kv_norm, kv_w_up):
    S = x.shape[1]
    cos, sin = rope_tables(S)
    k_nope = k_rope = v_shared = None
    for i in range(DEPTH):
        if i == N_A:
            k_nope, k_rope, v_shared = shared_kv(x, kv_w_down, kv_norm, kv_w_up, cos, sin)
        x = post_norm(x, 0.5 * swiglu(x, ffn1_w_in[i], ffn1_w_out[i]), ln_g[i, 0], ln_b[i, 0])
        if i < N_A:
            mix = fox_mixer(x, fox_w_in[i], fox_b_f[i], fox_w_o[i])
        else:
            j = i - N_A
            mix = mla_mixer(x, mla_w_dq[j], mla_q_norm[j], mla_w_uq[j], mla_w_o[j],
                            k_nope, k_rope, v_shared, cos, sin)
        x = post_norm(x, mix, ln_g[i, 1], ln_b[i, 1])
        x = post_norm(x, 0.5 * swiglu(x, ffn2_w_in[i], ffn2_w_out[i]), ln_g[i, 2], ln_b[i, 2])
        gate = jax.nn.sigmoid((x @ ple_w_gate[i] + ple_b_gate[i]).astype(jnp.float32)).astype(x.dtype)
        x = post_norm(x, gate * (p[i] @ ple_w_proj[i]), ln_g[i, 3], ln_b[i, 3])
    return x
```

```cpp
#include <hip/hip_runtime.h>
#include <hip/hip_cooperative_groups.h>
#include <cstdio>
#include <cstdint>
#include <cmath>
namespace cg = cooperative_groups;
#ifndef MULTI_LAUNCH
#define MULTI_LAUNCH 0
#endif
namespace pg8 {
#define PG8_LAS __attribute__((address_space(3)))
typedef unsigned short bf16_t;
typedef short bf16x8 __attribute__((ext_vector_type(8)));
typedef float f32x4 __attribute__((ext_vector_type(4)));
typedef unsigned u32x4 __attribute__((ext_vector_type(4)));
constexpr int BM = 256, BK = 64, HALF = 128, HTB = HALF * BK * 2  , STAGE_BYTES = 8 * HTB, NXCD = 8, WGM = 8;

__host__ __device__ __forceinline__ int lds_byte(int r, int c) { const int st = (r >> 4) * 2 + (c >> 5), rr = r & 15, cc = c & 31, ob = rr * 64 + cc * 2; return st * 1024 + (ob ^ (((ob >> 9) & 1) << 5)); }
__host__ __device__ __forceinline__ void stage_rc(int b, int& R, int& C) { const int st = b / 1024, sb = b % 1024, swz = sb ^ (((sb >> 9) & 1) << 5); R = (st >> 1) * 16 + swz / 64; C = (st & 1) * 32 + (swz % 64) / 2; }
__host__ __device__ __forceinline__ int perm32(int rho) { const int n = rho >> 4, i = rho & 15; return 8 * (i >> 2) + 4 * n + (i & 3); }

struct Unit { int pm, pn; };
struct Gemm { const bf16_t* A; const bf16_t* Bt; int M, N, K; };

struct StaticOrder {
    int nM, nN, nwg, G, c;
    __host__ __device__ void init(int M, int N, int G_, int c_) { nM = M / BM; nN = N / BM; nwg = nM * nN; G = G_; c = c_; }
    __host__ __device__ bool next(int i, Unit& u) const {
        const long L = (long)i * G + c; if (L >= nwg) return false;
        int wgid = (int)L; { const int q = nwg / NXCD, r = nwg % NXCD, xcd = wgid % NXCD, off = wgid / NXCD; wgid = (xcd < r ? xcd * (q + 1) : r * (q + 1) + (xcd - r) * q) + off; }
        const int nig = WGM * nN, gid = wgid / nig, fm = gid * WGM, gsz = (nM - fm) < WGM ? (nM - fm) : WGM;
        u.pm = fm + ((wgid % nig) % gsz); u.pn = (wgid % nig) / gsz; return true;
    }
    __device__ __forceinline__ void a_ready(const Unit&) const {}
    __device__ __forceinline__ void done(const Unit&) const {}
};
__device__ __forceinline__ unsigned cvt_pk_bf16(float lo, float hi) { unsigned r; asm volatile("v_cvt_pk_bf16_f32 %0, %1, %2" : "=v"(r) : "v"(lo), "v"(hi)); return r; }
typedef float f32x2 __attribute__((ext_vector_type(2)));
typedef unsigned u32x2 __attribute__((ext_vector_type(2)));
__device__ __forceinline__ float silu_f(float g) { return g * __builtin_amdgcn_rcpf(1.0f + __builtin_amdgcn_exp2f(-1.4426950408889634f * g)); }
__device__ __forceinline__ float sigm_f(float g) { return __builtin_amdgcn_rcpf(1.0f + __builtin_amdgcn_exp2f(-1.4426950408889634f * g)); }

struct EpiBf16P {
    static constexpr bool PERM = true, AFTER_DRAIN = false;
    bf16_t* O; int ldc;
    __device__ __forceinline__ void operator()(const f32x4 (&acc)[2][2][4][2], const Unit& u, int wr, int wc, int fr, int fq) const {
        asm volatile("" : "+v"(fr), "+v"(fq));
        const int row0 = u.pm * BM + wr * 64 + fr, col0 = u.pn * BM + wc * 32 + 8 * fq;
#pragma unroll
        for (int ai = 0; ai < 2; ++ai)
#pragma unroll
            for (int m = 0; m < 4; ++m) { bf16_t* rowp = O + (size_t)(row0 + ai * HALF + m * 16) * ldc + col0;
#pragma unroll
                for (int bj = 0; bj < 2; ++bj) { const f32x4 v0 = acc[ai][bj][m][0], v1 = acc[ai][bj][m][1];
                    u32x4 w; w.x = cvt_pk_bf16(v0[0], v0[1]); w.y = cvt_pk_bf16(v0[2], v0[3]); w.z = cvt_pk_bf16(v1[0], v1[1]); w.w = cvt_pk_bf16(v1[2], v1[3]);
                    *(u32x4*)(rowp + bj * HALF) = w; } }
    }
};
struct EpiSwiGLU {
    static constexpr bool PERM = true, AFTER_DRAIN = false;
    bf16_t* H; int ldh;
    __device__ __forceinline__ void operator()(const f32x4 (&acc)[2][2][4][2], const Unit& u, int wr, int wc, int fr, int fq) const {
        asm volatile("" : "+v"(fr), "+v"(fq));
        const int row0 = u.pm * BM + wr * 64 + fr, col0 = u.pn * HALF + wc * 32 + 8 * fq;
#pragma unroll
        for (int ai = 0; ai < 2; ++ai)
#pragma unroll
            for (int m = 0; m < 4; ++m) { bf16_t* rowp = H + (size_t)(row0 + ai * HALF + m * 16) * ldh + col0;
                const f32x4 g0 = acc[ai][0][m][0], g1 = acc[ai][0][m][1], u0 = acc[ai][1][m][0], u1 = acc[ai][1][m][1];
                u32x4 w;
                w.x = cvt_pk_bf16(silu_f(g0[0]) * u0[0], silu_f(g0[1]) * u0[1]); w.y = cvt_pk_bf16(silu_f(g0[2]) * u0[2], silu_f(g0[3]) * u0[3]);
                w.z = cvt_pk_bf16(silu_f(g1[0]) * u1[0], silu_f(g1[1]) * u1[1]); w.w = cvt_pk_bf16(silu_f(g1[2]) * u1[2], silu_f(g1[3]) * u1[3]);
                *(u32x4*)rowp = w; }
    }
};
struct EpiF32 {
    static constexpr bool PERM = false, AFTER_DRAIN = false;
    float* C; int ldc;
    __device__ __forceinline__ void operator()(const f32x4 (&acc)[2][2][4][2], const Unit& u, int wr, int wc, int fr, int fq) const {
        asm volatile("" : "+v"(fr), "+v"(fq));
        const int row0 = u.pm * BM + wr * 64 + fr, col0 = u.pn * BM + wc * 32 + 4 * fq;
#pragma unroll
        for (int ai = 0; ai < 2; ++ai)
#pragma unroll
            for (int m = 0; m < 4; ++m) { float* rowp = C + (size_t)(row0 + ai * HALF + m * 16) * ldc + col0;
#pragma unroll
                for (int bj = 0; bj < 2; ++bj)
#pragma unroll
                    for (int n = 0; n < 2; ++n) *(f32x4*)(rowp + bj * HALF + n * 16) = acc[ai][bj][m][n]; }
    }
};
struct EpiRes {
    static constexpr bool PERM = false, AFTER_DRAIN = false;
    float* Y; const float* Xin; const float* stats; const float* g; const float* b; float alpha, scale; int mode, row_off;
    __device__ __forceinline__ void operator()(const f32x4 (&acc)[2][2][4][2], const Unit& u, int wr, int wc, int fr, int fq) const {
        asm volatile("" : "+v"(fr), "+v"(fq));
        const int row0 = row_off + u.pm * BM + wr * 64 + fr, col0 = u.pn * BM + wc * 32 + 4 * fq;
#pragma unroll
        for (int bj = 0; bj < 2; ++bj)
#pragma unroll
            for (int n = 0; n < 2; ++n) { const int c = col0 + bj * HALF + n * 16;
                f32x4 gv = (f32x4){1.f, 1.f, 1.f, 1.f}, bv = (f32x4){0.f, 0.f, 0.f, 0.f};
                if (mode) { gv = *(const f32x4*)(g + c); bv = *(const f32x4*)(b + c); }
#pragma unroll
                for (int ai = 0; ai < 2; ++ai)
#pragma unroll
                    for (int m = 0; m < 4; ++m) { const int r = row0 + ai * HALF + m * 16; const size_t off = (size_t)r * 1024 + c;
                        f32x4 xo;
                        if (mode) { const f32x2 st = *(const f32x2*)(stats + 2 * (size_t)r); const f32x4 yo = *(const f32x4*)(Y + off); xo = (yo - st.x) * st.y * gv + bv; }
                        else xo = *(const f32x4*)(Xin + off);
                        *(f32x4*)(Y + off) = xo * alpha + acc[ai][bj][m][n] * scale; } }
    }
};
struct EpiPle {
    static constexpr bool PERM = true, AFTER_DRAIN = false;
    float* Y; const float* stats; const float* g; const float* b; const float* bg; const bf16_t* PP; float alpha;
    __device__ __forceinline__ void operator()(const f32x4 (&acc)[2][2][4][2], const Unit& u, int wr, int wc, int fr, int fq) const {
        asm volatile("" : "+v"(fr), "+v"(fq));
        const int row0 = u.pm * BM + wr * 64 + fr, col0 = u.pn * BM + wc * 32 + 8 * fq;
#pragma unroll
        for (int bj = 0; bj < 2; ++bj) { const int c = col0 + bj * HALF;
            const f32x4 g0 = *(const f32x4*)(g + c), g1 = *(const f32x4*)(g + c + 4), b0 = *(const f32x4*)(b + c), b1 = *(const f32x4*)(b + c + 4);
            const f32x4 q0 = *(const f32x4*)(bg + c), q1 = *(const f32x4*)(bg + c + 4);
#pragma unroll
            for (int ai = 0; ai < 2; ++ai)
#pragma unroll
                for (int m = 0; m < 4; ++m) { const int r = row0 + ai * HALF + m * 16; const size_t off = (size_t)r * 1024 + c;
                    const f32x2 st = *(const f32x2*)(stats + 2 * (size_t)r);
                    const f32x4 y0 = *(const f32x4*)(Y + off), y1 = *(const f32x4*)(Y + off + 4);
                    const u32x4 pw = *(const u32x4*)(PP + off);
                    const f32x4 x0 = (y0 - st.x) * st.y * g0 + b0, x1 = (y1 - st.x) * st.y * g1 + b1;
                    const f32x4 a0 = acc[ai][bj][m][0] + q0, a1 = acc[ai][bj][m][1] + q1;
                    f32x4 p0, p1;
                    p0[0] = __uint_as_float(pw.x << 16); p0[1] = __uint_as_float(pw.x & 0xffff0000u); p0[2] = __uint_as_float(pw.y << 16); p0[3] = __uint_as_float(pw.y & 0xffff0000u);
                    p1[0] = __uint_as_float(pw.z << 16); p1[1] = __uint_as_float(pw.z & 0xffff0000u); p1[2] = __uint_as_float(pw.w << 16); p1[3] = __uint_as_float(pw.w & 0xffff0000u);
                    f32x4 o0, o1;
#pragma unroll
                    for (int e = 0; e < 4; ++e) { o0[e] = x0[e] * alpha + sigm_f(a0[e]) * p0[e]; o1[e] = x1[e] * alpha + sigm_f(a1[e]) * p1[e]; }
                    *(f32x4*)(Y + off) = o0; *(f32x4*)(Y + off + 4) = o1; asm volatile("" ::: "memory"); } }
    }
};
struct EpiFox {
    static constexpr bool PERM = true, AFTER_DRAIN = false;
    bf16_t* Q; bf16_t* K; bf16_t* V; float* flog; float qscale;
    __device__ __forceinline__ void operator()(const f32x4 (&acc)[2][2][4][2], const Unit& u, int wr, int wc, int fr, int fq) const {
        asm volatile("" : "+v"(fr), "+v"(fq));
        const int row0 = u.pm * BM + wr * 64 + fr;
        if (u.pn == 12) {
            if (wc == 0 && fq < 2) {
#pragma unroll
                for (int ai = 0; ai < 2; ++ai)
#pragma unroll
                    for (int m = 0; m < 4; ++m) { float* p = flog + (size_t)(row0 + ai * HALF + m * 16) * 16 + 8 * fq;
                        *(f32x4*)p = acc[ai][0][m][0]; *(f32x4*)(p + 4) = acc[ai][0][m][1]; }
            }
            return;
        }
        const int t = u.pn >> 2; bf16_t* base = Q + (size_t)t * ((size_t)64 << 19); const float sc = t == 0 ? qscale : 1.0f;
        const int col0 = (u.pn & 3) * BM + wc * 32 + 8 * fq;
#pragma unroll
        for (int ai = 0; ai < 2; ++ai)
#pragma unroll
            for (int m = 0; m < 4; ++m) { bf16_t* rowp = base + (size_t)(row0 + ai * HALF + m * 16) * 1024 + col0;
#pragma unroll
                for (int bj = 0; bj < 2; ++bj) { const f32x4 v0 = acc[ai][bj][m][0] * sc, v1 = acc[ai][bj][m][1] * sc;
                    u32x4 w; w.x = cvt_pk_bf16(v0[0], v0[1]); w.y = cvt_pk_bf16(v0[2], v0[3]); w.z = cvt_pk_bf16(v1[0], v1[1]); w.w = cvt_pk_bf16(v1[2], v1[3]);
                    *(u32x4*)(rowp + bj * HALF) = w; } }
    }
};
struct EpiQ {
    static constexpr bool PERM = true, AFTER_DRAIN = false;
    bf16_t* QM; const float* rcos; const float* rsin; float qscale;
    __device__ __forceinline__ void operator()(const f32x4 (&acc)[2][2][4][2], const Unit& u, int wr, int wc, int fr, int fq) const {
        asm volatile("" : "+v"(fr), "+v"(fq));
        const int row0 = u.pm * BM + wr * 64 + fr, col0 = u.pn * BM + wc * 32 + 8 * fq;
#pragma unroll
        for (int bj = 0; bj < 2; ++bj) { const int c = col0 + bj * HALF; const int w0 = c % 192; const bool rp = w0 >= 128; const int i0 = rp ? (w0 - 128) >> 1 : 0;
#pragma unroll
            for (int ai = 0; ai < 2; ++ai)
#pragma unroll
                for (int m = 0; m < 4; ++m) { const int r = row0 + ai * HALF + m * 16;
                    f32x4 v0 = acc[ai][bj][m][0], v1 = acc[ai][bj][m][1];
                    if (rp) { const int pos = r & 4095; const f32x4 cs = *(const f32x4*)(rcos + pos * 32 + i0), sn = *(const f32x4*)(rsin + pos * 32 + i0);
                        f32x4 t0, t1;
                        t0[0] = v0[0] * cs[0] - v0[1] * sn[0]; t0[1] = v0[1] * cs[0] + v0[0] * sn[0]; t0[2] = v0[2] * cs[1] - v0[3] * sn[1]; t0[3] = v0[3] * cs[1] + v0[2] * sn[1];
                        t1[0] = v1[0] * cs[2] - v1[1] * sn[2]; t1[1] = v1[1] * cs[2] + v1[0] * sn[2]; t1[2] = v1[2] * cs[3] - v1[3] * sn[3]; t1[3] = v1[3] * cs[3] + v1[2] * sn[3];
                        v0 = t0; v1 = t1; }
                    v0 = v0 * qscale; v1 = v1 * qscale;
                    u32x4 w; w.x = cvt_pk_bf16(v0[0], v0[1]); w.y = cvt_pk_bf16(v0[2], v0[3]); w.z = cvt_pk_bf16(v1[0], v1[1]); w.w = cvt_pk_bf16(v1[2], v1[3]);
                    *(u32x4*)(QM + (size_t)r * 3072 + c) = w; asm volatile("" ::: "memory"); } }
    }
};
struct EpiKV {
    static constexpr bool PERM = true, AFTER_DRAIN = false;
    bf16_t* KN; bf16_t* VV;
    __device__ __forceinline__ void operator()(const f32x4 (&acc)[2][2][4][2], const Unit& u, int wr, int wc, int fr, int fq) const {
        asm volatile("" : "+v"(fr), "+v"(fq));
        const int row0 = u.pm * BM + wr * 64 + fr, col0 = u.pn * HALF + wc * 32 + 8 * fq;
#pragma unroll
        for (int ai = 0; ai < 2; ++ai)
#pragma unroll
            for (int m = 0; m < 4; ++m) { const size_t off = (size_t)(row0 + ai * HALF + m * 16) * 2048 + col0;
#pragma unroll
                for (int bj = 0; bj < 2; ++bj) { const f32x4 v0 = acc[ai][bj][m][0], v1 = acc[ai][bj][m][1];
                    u32x4 w; w.x = cvt_pk_bf16(v0[0], v0[1]); w.y = cvt_pk_bf16(v0[2], v0[3]); w.z = cvt_pk_bf16(v1[0], v1[1]); w.w = cvt_pk_bf16(v1[2], v1[3]);
                    *(u32x4*)((bj == 0 ? KN : VV) + off) = w; } }
    }
};
template <class Epi, class Sched, bool ALIGN_EPI = false, bool SP2 = false>
__device__ __forceinline__ void gemm_phase(PG8_LAS unsigned char* lds, const Gemm g, const Sched& S, const Epi& E) {
    int tid_ = threadIdx.x; asm volatile("" : "+v"(tid_));
    const int tid = tid_, wid = __builtin_amdgcn_readfirstlane(tid >> 6), lane = tid & 63, wr = wid >> 2, wc = wid & 3, fr = lane & 15, fq = lane >> 4;
    const int K = g.K, nt = K / BK;
    unsigned voffA[2], voffB[2];
#pragma unroll
    for (int i = 0; i < 2; ++i) { int R, C; stage_rc(tid * 16 + i * 8192, R, C); const int Rb = Epi::PERM ? ((R & ~31) + perm32(R & 31)) : R;
        voffA[i] = (unsigned)(R * K + C) * 2u; voffB[i] = (unsigned)(Rb * K + C) * 2u; }
    const size_t kstep = (size_t)(BK * 2);
    const size_t hstep = (size_t)HALF * K * 2;
    const size_t tstep = 2 * hstep;
    const unsigned ldsw = (unsigned)wid * 1024u;
    const int aoff = lds_byte(wr * 64 + fr, fq * 8), boff = lds_byte(wc * 32 + fr, fq * 8);
#define PG8_SA(b, h) (((b) * 2 + (h)) * HTB)
#define PG8_SB(b, h) ((4 + (b) * 2 + (h)) * HTB)
#define PG8_STAGE(bufoff, gbase, voff) do { _Pragma("unroll") for (int _i = 0; _i < 2; ++_i) \
        __builtin_amdgcn_global_load_lds((const unsigned*)((const char*)(gbase) + (voff)[_i]), (PG8_LAS unsigned*)(lds + (bufoff) + ldsw + _i * 8192), 16, 0, 0); } while (0)
#define PG8_LDA(dst, b, h) do { _Pragma("unroll") for (int m = 0; m < 4; ++m) _Pragma("unroll") for (int k = 0; k < 2; ++k) dst[m][k] = *(const PG8_LAS bf16x8*)(lds + PG8_SA(b, h) + aoff + m * 2048 + k * 1024); } while (0)
#define PG8_LDB(dst, b, h) do { _Pragma("unroll") for (int n = 0; n < 2; ++n) _Pragma("unroll") for (int k = 0; k < 2; ++k) dst[n][k] = *(const PG8_LAS bf16x8*)(lds + PG8_SB(b, h) + boff + n * 2048 + k * 1024); } while (0)
#define PG8_MMA(ai, bj, At, Bt) do { __builtin_amdgcn_s_setprio(1); _Pragma("unroll") for (int m = 0; m < 4; ++m) _Pragma("unroll") for (int n = 0; n < 2; ++n) _Pragma("unroll") for (int k = 0; k < 2; ++k) \
        acc[ai][bj][m][n] = __builtin_amdgcn_mfma_f32_16x16x32_bf16(Bt[n][k], At[m][k], acc[ai][bj][m][n], 0, 0, 0); __builtin_amdgcn_s_setprio(0); } while (0)
#define PG8_WAIT_V(n) asm volatile("s_waitcnt vmcnt(" #n ")" ::: "memory")
#define PG8_WAIT_L(n) asm volatile("s_waitcnt lgkmcnt(" #n ")" ::: "memory")
#define PG8_BAR __builtin_amdgcn_s_barrier()
#define PG8_SCHED __builtin_amdgcn_sched_barrier(0)
    Unit cur, nxt; int ui = 0;
    if (!S.next(0, cur)) return;
    f32x4 acc[2][2][4][2];
#pragma unroll
    for (int a = 0; a < 2; ++a)
#pragma unroll
        for (int b = 0; b < 2; ++b)
#pragma unroll
            for (int m = 0; m < 4; ++m)
#pragma unroll
                for (int n = 0; n < 2; ++n) acc[a][b][m][n] = (f32x4){0.f, 0.f, 0.f, 0.f};
    bf16x8 At[4][2], B0[2][2], B1[2][2];
    const char* cA = (const char*)g.A + (size_t)cur.pm * tstep; const char* cB = (const char*)g.Bt + (size_t)cur.pn * tstep;
    S.a_ready(cur);
    if constexpr (SP2) {
        PG8_STAGE(PG8_SB(0, 0), cB, voffB); PG8_STAGE(PG8_SB(0, 1), cB + hstep, voffB); PG8_STAGE(PG8_SA(0, 0), cA, voffA); PG8_STAGE(PG8_SA(0, 1), cA + hstep, voffA);
        if (wr == 1) PG8_BAR;
        PG8_WAIT_V(2); PG8_BAR;
        PG8_STAGE(PG8_SB(1, 0), cB + kstep, voffB); PG8_STAGE(PG8_SA(1, 0), cA + kstep, voffA); PG8_STAGE(PG8_SB(1, 1), cB + hstep + kstep, voffB);
        PG8_WAIT_V(6); PG8_BAR;
    } else {
        PG8_STAGE(PG8_SB(0, 0), cB, voffB); PG8_STAGE(PG8_SA(0, 0), cA, voffA); PG8_STAGE(PG8_SB(0, 1), cB + hstep, voffB); PG8_STAGE(PG8_SA(0, 1), cA + hstep, voffA);
        if (wr == 1) PG8_BAR;
        PG8_WAIT_V(4); PG8_BAR;
        PG8_STAGE(PG8_SB(1, 0), cB + kstep, voffB); PG8_STAGE(PG8_SA(1, 0), cA + kstep, voffA); PG8_STAGE(PG8_SB(1, 1), cB + hstep + kstep, voffB);
        PG8_WAIT_V(6); PG8_BAR;
    }
    for (;;) {
        const bool has_next = S.next(ui + 1, nxt);
        const char* nA = has_next ? (const char*)g.A + (size_t)nxt.pm * tstep : cA; const char* nB = has_next ? (const char*)g.Bt + (size_t)nxt.pn * tstep : cB;
        for (int t = 0; t < nt; t += 2) {
            const bool last = (t == nt - 2);
            const char* a1 = cA + (size_t)(t + 1) * kstep;
            const char* a2 = last ? nA : cA + (size_t)(t + 2) * kstep; const char* b2 = last ? nB : cB + (size_t)(t + 2) * kstep;
            const char* a3 = a2 + kstep; const char* b3 = b2 + kstep;
            if (last && has_next) S.a_ready(nxt);
            if constexpr (SP2) {
            PG8_LDB(B0, 0, 0); PG8_LDB(B1, 0, 1); PG8_SCHED; PG8_LDA(At, 0, 0); PG8_STAGE(PG8_SA(1, 1), a1 + hstep, voffA);
            PG8_WAIT_V(8); PG8_WAIT_L(0); PG8_BAR; PG8_MMA(0, 0, At, B0); PG8_MMA(0, 1, At, B1); PG8_BAR; PG8_SCHED;
            PG8_LDA(At, 0, 1); PG8_STAGE(PG8_SB(0, 0), b2, voffB); PG8_STAGE(PG8_SB(0, 1), b2 + hstep, voffB); PG8_STAGE(PG8_SA(0, 0), a2, voffA);
            PG8_WAIT_V(8); PG8_WAIT_L(0); PG8_BAR; PG8_MMA(1, 0, At, B0); PG8_MMA(1, 1, At, B1); PG8_BAR; PG8_SCHED;
            PG8_LDB(B0, 1, 0); PG8_LDB(B1, 1, 1); PG8_SCHED; PG8_LDA(At, 1, 0); PG8_STAGE(PG8_SA(0, 1), a2 + hstep, voffA);
            PG8_WAIT_V(8); PG8_WAIT_L(0); PG8_BAR; PG8_MMA(0, 0, At, B0); PG8_MMA(0, 1, At, B1); PG8_BAR; PG8_SCHED;
            PG8_LDA(At, 1, 1); PG8_STAGE(PG8_SB(1, 0), b3, voffB); PG8_STAGE(PG8_SB(1, 1), b3 + hstep, voffB); PG8_STAGE(PG8_SA(1, 0), a3, voffA);
            PG8_WAIT_V(8); PG8_WAIT_L(0); PG8_BAR; PG8_MMA(1, 0, At, B0); PG8_MMA(1, 1, At, B1); PG8_BAR; PG8_SCHED;
            } else {
            PG8_LDB(B0, 0, 0); PG8_SCHED; PG8_LDA(At, 0, 0); PG8_STAGE(PG8_SA(1, 1), a1 + hstep, voffA);
            PG8_WAIT_L(8); PG8_BAR; PG8_WAIT_L(0); PG8_MMA(0, 0, At, B0); PG8_BAR; PG8_SCHED;
            PG8_LDB(B1, 0, 1); PG8_STAGE(PG8_SB(0, 0), b2, voffB);
            PG8_BAR; PG8_WAIT_L(0); PG8_MMA(0, 1, At, B1); PG8_BAR;
            PG8_LDA(At, 0, 1); PG8_STAGE(PG8_SA(0, 0), a2, voffA);
            PG8_BAR; PG8_WAIT_L(0); PG8_MMA(1, 0, At, B0); PG8_BAR; PG8_SCHED;
            PG8_STAGE(PG8_SB(0, 1), b2 + hstep, voffB);
            PG8_WAIT_V(6); PG8_BAR; PG8_MMA(1, 1, At, B1); PG8_BAR;
            PG8_LDB(B0, 1, 0); PG8_SCHED; PG8_LDA(At, 1, 0); PG8_STAGE(PG8_SA(0, 1), a2 + hstep, voffA);
            PG8_WAIT_L(8); PG8_BAR; PG8_WAIT_L(0); PG8_MMA(0, 0, At, B0); PG8_BAR; PG8_SCHED;
            PG8_LDB(B1, 1, 1); PG8_STAGE(PG8_SB(1, 0), b3, voffB);
            PG8_BAR; PG8_WAIT_L(0); PG8_MMA(0, 1, At, B1); PG8_BAR;
            PG8_LDA(At, 1, 1); PG8_STAGE(PG8_SA(1, 0), a3, voffA);
            PG8_BAR; PG8_WAIT_L(0); PG8_MMA(1, 0, At, B0); PG8_BAR; PG8_SCHED;
            PG8_STAGE(PG8_SB(1, 1), b3 + hstep, voffB);
            PG8_WAIT_V(6); PG8_BAR; PG8_MMA(1, 1, At, B1); PG8_BAR;
            }
        }
        if constexpr (ALIGN_EPI) { if (wr == 0) PG8_BAR; }
        if constexpr (!Epi::AFTER_DRAIN) { E(acc, cur, wr, wc, fr, fq); S.done(cur); }
        if (!has_next) break;
#pragma unroll
        for (int a = 0; a < 2; ++a)
#pragma unroll
            for (int b = 0; b < 2; ++b)
#pragma unroll
                for (int m = 0; m < 4; ++m)
#pragma unroll
                    for (int n = 0; n < 2; ++n) acc[a][b][m][n] = (f32x4){0.f, 0.f, 0.f, 0.f};
        cur = nxt; cA = nA; cB = nB; ++ui;
        if constexpr (ALIGN_EPI) { if (wr == 1) PG8_BAR; }
    }
    PG8_WAIT_V(0);
    if constexpr (!ALIGN_EPI) { if (wr == 0) PG8_BAR; }
    PG8_BAR;
    if constexpr (Epi::AFTER_DRAIN) { E.fused(acc, cur, wr, wc, fr, fq, lds, wid, lane); S.done(cur); }
#undef PG8_SA
#undef PG8_SB
#undef PG8_STAGE
#undef PG8_LDA
#undef PG8_LDB
#undef PG8_MMA
#undef PG8_WAIT_V
#undef PG8_WAIT_L
#undef PG8_BAR
#undef PG8_SCHED
}
}
namespace att {
#define ALAS __attribute__((address_space(3)))
typedef unsigned short bf16_t;
typedef short bf16x8 __attribute__((ext_vector_type(8)));
typedef short s16x4 __attribute__((ext_vector_type(4)));
typedef float f32x16 __attribute__((ext_vector_type(16)));
typedef float f32x4 __attribute__((ext_vector_type(4)));
typedef unsigned u32x4 __attribute__((ext_vector_type(4)));
typedef unsigned u32x2 __attribute__((ext_vector_type(2)));
typedef float f32x2_t __attribute__((ext_vector_type(2))); typedef __bf16 bf16x2_t __attribute__((ext_vector_type(2)));
__device__ __forceinline__ unsigned cvtpk(float lo, float hi) { f32x2_t v = {lo, hi}; bf16x2_t b = __builtin_convertvector(v, bf16x2_t); return __builtin_bit_cast(unsigned, b); }
__device__ __forceinline__ s16x4 vtr(const ALAS unsigned char* p) { return __builtin_bit_cast(s16x4, __builtin_amdgcn_ds_read_tr16_b64_v4i16((ALAS s16x4*)p)); }

template <int DQK, int DN, int DV, bool BIAS>
__device__ __forceinline__ void attn_unit(ALAS unsigned char* lds, const unsigned char* wsb, unsigned qoff, int qp, unsigned knoff, int knp, unsigned kroff, int krp,
                                          unsigned voff, int vp, unsigned ooff, int op, const float* nb, int q0) {
    constexpr int KP = DQK * 2 + 16, KBUF = 64 * KP, VBUF = 64 * DV * 2, OFF_V = 2 * KBUF, OFF_B = OFF_V + 2 * VBUF;
    constexpr int NKN = DN / 64, NKR = (DQK - DN) / 64, NVC = DV / 64, NST = DQK / 16, NDB = DV / 32;
    int tid_ = threadIdx.x; asm volatile("" : "+v"(tid_));
    const int tid = tid_, lane = tid & 63, r32 = lane & 31, hi = lane >> 5; const int wid = __builtin_amdgcn_readfirstlane(tid >> 6);
    const int NT = (q0 + 256) / 64;
    const int qrow = q0 + 32 * wid + r32, qmin = q0 + 32 * wid, qmax = qmin + 31;
    const int skey = tid >> 3, sc = tid & 7;
    const unsigned lkn = (unsigned)(skey * knp * 2 + sc * 16), lkr = (unsigned)(skey * krp * 2 + sc * 16), lv = (unsigned)(skey * vp * 2 + sc * 16);
    const unsigned tkn = 64u * (unsigned)knp * 2u, tkr = 64u * (unsigned)krp * 2u, tv = 64u * (unsigned)vp * 2u;
    u32x4 kreg[NKN + NKR], vreg[NVC]; f32x4 breg = (f32x4){0.f, 0.f, 0.f, 0.f};
#define ATT_LOADK(t) do { \
    _Pragma("unroll") for (int i_ = 0; i_ < NKN; ++i_) kreg[i_] = *(const u32x4*)(wsb + (size_t)(knoff + (unsigned)(t) * tkn + lkn) + i_ * 128); \
    _Pragma("unroll") for (int i_ = 0; i_ < NKR; ++i_) kreg[NKN + i_] = *(const u32x4*)(wsb + (size_t)(kroff + (unsigned)(t) * tkr + lkr) + i_ * 128); \
    if (BIAS) { if (tid < 16) breg = *(const f32x4*)(nb + 64 * (t) + 4 * tid); } } while (0)
#define ATT_LOADV(t) do { \
    _Pragma("unroll") for (int i_ = 0; i_ < NVC; ++i_) vreg[i_] = *(const u32x4*)(wsb + (size_t)(voff + (unsigned)(t) * tv + lv) + i_ * 128); } while (0)
#define ATT_STORE(buf) do { \
    _Pragma("unroll") for (int i_ = 0; i_ < NKN + NKR; ++i_) *(ALAS u32x4*)(lds + (buf) * KBUF + skey * KP + sc * 16 + i_ * 128) = kreg[i_]; \
    _Pragma("unroll") for (int i_ = 0; i_ < NVC; ++i_) *(ALAS u32x4*)(lds + OFF_V + (buf) * VBUF + (2 * i_ + (sc >> 2)) * 4096 + skey * 64 + (sc & 3) * 16) = vreg[i_]; \
    if (BIAS) { if (tid < 16) *(ALAS f32x4*)(lds + OFF_B + (buf) * 256 + tid * 16) = breg; } } while (0)
    ATT_LOADK(0); ATT_LOADV(0);
    bf16x8 qr[NST];
#pragma unroll
    for (int st = 0; st < NST; ++st) qr[st] = *(const bf16x8*)(wsb + (size_t)(qoff + (unsigned)(qrow * qp * 2 + 16 * hi)) + 32 * st);
    f32x16 o[NDB];
#pragma unroll
    for (int db = 0; db < NDB; ++db)
#pragma unroll
        for (int r = 0; r < 16; ++r) o[db][r] = 0.f;
    float mrun = -INFINITY, lrun = 0.f;
    ATT_STORE(0);
    __syncthreads();
    for (int t = 0; t < NT; ++t) {
        const int buf = t & 1;
        if (t + 1 < NT) ATT_LOADK(t + 1);
        if (64 * t <= qmax) {
            const ALAS unsigned char* kb = lds + buf * KBUF + r32 * KP + hi * 16;
            f32x16 p0, p1;
#pragma unroll
            for (int r = 0; r < 16; ++r) { p0[r] = 0.f; p1[r] = 0.f; }
#pragma unroll
            for (int st = 0; st < NST; ++st) {
                const bf16x8 k0 = *(const ALAS bf16x8*)(kb + st * 32), k1 = *(const ALAS bf16x8*)(kb + 32 * KP + st * 32);
                p0 = __builtin_amdgcn_mfma_f32_32x32x16_bf16(k0, qr[st], p0, 0, 0, 0);
                p1 = __builtin_amdgcn_mfma_f32_32x32x16_bf16(k1, qr[st], p1, 0, 0, 0);
            }
            if (BIAS) {
                const ALAS float* bb = (const ALAS float*)(lds + OFF_B + buf * 256);
#pragma unroll
                for (int g = 0; g < 4; ++g) { const f32x4 b0 = *(const ALAS f32x4*)(bb + 8 * g + 4 * hi), b1 = *(const ALAS f32x4*)(bb + 32 + 8 * g + 4 * hi);
#pragma unroll
                    for (int e = 0; e < 4; ++e) { p0[4 * g + e] += b0[e]; p1[4 * g + e] += b1[e]; } }
            }
            if (64 * t + 63 > qmin) {
#pragma unroll
                for (int r = 0; r < 16; ++r) { const int key = 64 * t + (r & 3) + 8 * (r >> 2) + 4 * hi;
                    if (key > qrow) p0[r] = -INFINITY; if (key + 32 > qrow) p1[r] = -INFINITY; }
            }
            float mx = fmaxf(p0[0], p1[0]);
#pragma unroll
            for (int r = 1; r < 16; ++r) mx = fmaxf(mx, fmaxf(p0[r], p1[r]));
            mx = fmaxf(mx, __shfl_xor(mx, 32));
            const float mn = fmaxf(mrun, mx), al = __builtin_amdgcn_exp2f(mrun - mn);
            mrun = mn;
            float sum = 0.f;
#pragma unroll
            for (int r = 0; r < 16; ++r) { p0[r] = __builtin_amdgcn_exp2f(p0[r] - mn); p1[r] = __builtin_amdgcn_exp2f(p1[r] - mn); sum += p0[r] + p1[r]; }
            lrun = lrun * al + sum;
            if (__any(al != 1.0f)) {
#pragma unroll
                for (int db = 0; db < NDB; ++db)
#pragma unroll
                    for (int r = 0; r < 16; ++r) o[db][r] *= al;
            }
            u32x4 pw[4];
#pragma unroll
            for (int s = 0; s < 2; ++s) {
                pw[s] = (u32x4){cvtpk(p0[8 * s], p0[8 * s + 1]), cvtpk(p0[8 * s + 2], p0[8 * s + 3]), cvtpk(p0[8 * s + 4], p0[8 * s + 5]), cvtpk(p0[8 * s + 6], p0[8 * s + 7])};
                pw[2 + s] = (u32x4){cvtpk(p1[8 * s], p1[8 * s + 1]), cvtpk(p1[8 * s + 2], p1[8 * s + 3]), cvtpk(p1[8 * s + 4], p1[8 * s + 5]), cvtpk(p1[8 * s + 6], p1[8 * s + 7])};
            }
            __builtin_amdgcn_sched_barrier(0);
            if (t + 1 < NT) ATT_LOADV(t + 1);
            const ALAS unsigned char* vb = lds + OFF_V + buf * VBUF + ((lane >> 4) & 1) * 32 + (lane & 3) * 8 + (4 * hi + ((lane & 15) >> 2)) * 64;
#pragma unroll
            for (int db = 0; db < NDB; ++db)
#pragma unroll
                for (int s = 0; s < 4; ++s) {
                    const s16x4 lo = vtr(vb + db * 4096 + s * 1024), hh = vtr(vb + db * 4096 + s * 1024 + 512);
                    const bf16x8 vf = (bf16x8){lo[0], lo[1], lo[2], lo[3], hh[0], hh[1], hh[2], hh[3]};
                    o[db] = __builtin_amdgcn_mfma_f32_32x32x16_bf16(vf, __builtin_bit_cast(bf16x8, pw[s]), o[db], 0, 0, 0);
                    if (s == 3) __builtin_amdgcn_sched_barrier(0);
                }
        }
        if (t + 1 < NT) { if (64 * t > qmax) ATT_LOADV(t + 1); ATT_STORE(buf ^ 1); }
        __syncthreads();
    }
    const float lt = lrun + __shfl_xor(lrun, 32), inv = 1.0f / lt;
    bf16_t* orow = (bf16_t*)(const_cast<unsigned char*>(wsb) + (size_t)(ooff + (unsigned)(qrow * op * 2 + 8 * hi)));
#pragma unroll
    for (int db = 0; db < NDB; ++db)
#pragma unroll
        for (int g = 0; g < 4; ++g) { u32x2 w; w.x = cvtpk(o[db][4 * g] * inv, o[db][4 * g + 1] * inv); w.y = cvtpk(o[db][4 * g + 2] * inv, o[db][4 * g + 3] * inv);
            *(u32x2*)(orow + 32 * db + 8 * g) = w; }
#undef ATT_LOADK
#undef ATT_LOADV
#undef ATT_STORE
}
}
#define LAS __attribute__((address_space(3)))
typedef unsigned short bf16;
typedef float f32x4 __attribute__((ext_vector_type(4)));
typedef float f32x2 __attribute__((ext_vector_type(2)));
typedef unsigned u32x4 __attribute__((ext_vector_type(4)));
typedef unsigned u32x2 __attribute__((ext_vector_type(2)));
constexpr int NB = 8, SEQ = 4096, DM = 1024, MT = NB * SEQ, DFF = 2816, PLED = 256, MH = MT / 2;
constexpr float ALPHA = 1.4142135623730951f, LN_EPS = 1e-5f, RMS_EPS = 1e-6f, LOG2E = 1.4426950408889634f;
constexpr size_t MiB = 1u << 20, QMiB = 1u << 18;
constexpr size_t WS_FIN = 0;
constexpr size_t WS_FOUT = 44 * MiB;
constexpr size_t WS_PG = 66 * MiB;
constexpr size_t WS_PP = 70 * MiB;
constexpr size_t WS_FOXIN = 71 * MiB;
constexpr size_t WS_FOXO = 71 * MiB + 26 * QMiB;
constexpr size_t WS_DQ = WS_FOXO + 2 * MiB;
constexpr size_t WS_UQ = WS_DQ + 1 * MiB;
constexpr size_t WS_MO = WS_UQ + 9 * QMiB;
constexpr size_t WS_KVD = WS_MO + 4 * MiB;
constexpr size_t WS_KVUP = WS_KVD + 1 * MiB;
constexpr size_t WS_RCOS = 90 * MiB, WS_RSIN = 90 * MiB + 2 * QMiB;
constexpr size_t WS_STATS = 91 * MiB;
constexpr size_t WS_CTL = 91 * MiB + 2 * QMiB;
constexpr size_t CTL_BYTES = 64 * 1024;
constexpr size_t WS_XB = 92 * MiB;
constexpr size_t WS_CKV = 156 * MiB;
constexpr size_t WS_KROPE = 172 * MiB;
constexpr size_t WS_CQB = 176 * MiB;
constexpr size_t WS_R = 200 * MiB;
constexpr size_t WS_H = WS_R;
constexpr size_t WS_KVDF = WS_R + 176 * MiB;
constexpr size_t WS_FQ = WS_R, WS_FK = WS_R + 64 * MiB, WS_FV = WS_R + 128 * MiB, WS_FLOG = WS_R + 192 * MiB, WS_FNB = WS_R + 194 * MiB;
constexpr size_t WS_PBF = WS_R, WS_PPA = WS_R + 16 * MiB;
constexpr size_t WS_CQF = WS_R;
constexpr size_t WS_QM = WS_R, WS_KN = WS_R + 96 * MiB, WS_VV = WS_R + 160 * MiB, WS_OO = WS_R + 224 * MiB;
constexpr size_t WS_END = 512 * MiB;
static_assert(WS_KVUP + 2 * MiB <= WS_RCOS && WS_OO + 64 * MiB <= WS_END && WS_KVDF + 64 * MiB <= WS_END, "ws map");

constexpr int LDS_BYTES = 147456;
constexpr int NPHASE = 30;

struct Args { const float* in[21]; float* out; unsigned char* ws; int lo, hi, G, pad; };
static_assert(sizeof(Args) == 200, "Args layout");
__device__ const double ROPE_INV[32] = {1.0, 0.7498942093324559, 0.5623413251903491, 0.4216965034285822, 0.31622776601683794, 0.23713737056616552, 0.1778279410038923, 0.1333521432163324, 0.1, 0.07498942093324558, 0.05623413251903491, 0.042169650342858224, 0.03162277660168379, 0.023713737056616554, 0.01778279410038923, 0.01333521432163324, 0.01, 0.007498942093324558, 0.005623413251903491, 0.004216965034285823, 0.0031622776601683794, 0.0023713737056616554, 0.0017782794100389228, 0.001333521432163324, 0.001, 0.0007498942093324559, 0.0005623413251903491, 0.00042169650342858224, 0.00031622776601683794, 0.00023713737056616554, 0.00017782794100389227, 0.0001333521432163324};

__device__ __forceinline__ unsigned f2bf(float f) { unsigned u = __builtin_bit_cast(unsigned, f); return (u + 0x7fffu + ((u >> 16) & 1u)) >> 16; }
__device__ __forceinline__ unsigned pk2(float lo, float hi) { return f2bf(lo) | (f2bf(hi) << 16); }
__device__ __forceinline__ float wave_sum(float v) {
#pragma unroll
    for (int o = 1; o < 64; o <<= 1) v += __shfl_xor(v, o);
    return v;
}
struct Ctx { int tid, lane, wave, vcu, G, gw, NGW, bx; LAS unsigned char* lds; };

__device__ __forceinline__ int dst_row(int n, int mode) {
    if (mode == 1) { const int up = n >= DFF ? 1 : 0, j = n - up * DFF; return (j >> 7) * 256 + up * 128 + (j & 127); }
    if (mode == 2) { const int h = n / 192, w = n % 192; if (w < 128) return n; const int i = w - 128; return h * 192 + 128 + 2 * (i & 31) + (i >> 5); }
    return n;
}
__device__ __forceinline__ void transpose_mat(const Ctx& C, const float* W, int K, int N, bf16* WT, int mode) {
    LAS float* scr = (LAS float*)(C.lds + C.wave * 16384);
    const int nblk = (N + 31) / 32, nitems = (K / 64) * nblk, lane = C.lane;
    for (int it = C.gw; it < nitems; it += C.NGW) {
        const int kb = it / nblk, nb = it % nblk, k0 = 64 * kb, n0 = 32 * nb;
        const int nn = n0 + (lane & 31);
#pragma unroll 8
        for (int i = 0; i < 32; ++i) { const int kk = 2 * i + (lane >> 5); scr[kk * 33 + (lane & 31)] = nn < N ? W[(size_t)(k0 + kk) * N + nn] : 0.f; }
        asm volatile("s_waitcnt lgkmcnt(0)" ::: "memory");
        const int c = lane & 7;
#pragma unroll
        for (int j = 0; j < 4; ++j) { const int nl = (lane >> 3) + 8 * j, n = n0 + nl; const LAS float* s = scr + (8 * c) * 33 + nl;
            u32x4 o; o.x = pk2(s[0 * 33], s[1 * 33]); o.y = pk2(s[2 * 33], s[3 * 33]); o.z = pk2(s[4 * 33], s[5 * 33]); o.w = pk2(s[6 * 33], s[7 * 33]);
            if (n < N) *(u32x4*)(WT + (size_t)dst_row(n, mode) * K + k0 + 8 * c) = o; }
        asm volatile("s_waitcnt lgkmcnt(0)" ::: "memory");
    }
}
__device__ __forceinline__ void zero_rows(const Ctx& C, bf16* WT, int K, int r0, int r1) {
    const size_t n16 = (size_t)(r1 - r0) * K / 8; u32x4* p = (u32x4*)(WT + (size_t)r0 * K);
    for (size_t i = (size_t)C.gw * 64 + C.lane; i < n16; i += (size_t)C.NGW * 64) p[i] = (u32x4){0u, 0u, 0u, 0u};
}
__device__ __forceinline__ void cvt_rows(const Ctx& C, const float* src, bf16* dst, size_t n) {
    const size_t n8 = n / 8;
    for (size_t i = (size_t)C.gw * 64 + C.lane; i < n8; i += (size_t)C.NGW * 64) { const f32x4 a = *(const f32x4*)(src + 8 * i), b = *(const f32x4*)(src + 8 * i + 4);
        *(u32x4*)(dst + 8 * i) = (u32x4){pk2(a.x, a.y), pk2(a.z, a.w), pk2(b.x, b.y), pk2(b.z, b.w)}; }
}
__device__ __forceinline__ void rope_tables(const Ctx& C, float* rc, float* rs) {
    for (int idx = C.gw * 64 + C.lane; idx < SEQ * 32; idx += C.NGW * 64) {
        const int pos = idx >> 5, i = idx & 31; const double ang = (double)pos * ROPE_INV[i];
        const double k = __builtin_rint(ang * 0.15915494309189535); double r = __builtin_fma(-k, 6.283185307179586, ang); r = __builtin_fma(-k, 2.4492935982947064e-16, r);
        const double r2 = r * r; double sn = 0.0, cs = 0.0;
#pragma unroll
        for (int n = 16; n >= 1; --n) { sn = (1.0 - sn) * (r2 * (1.0 / (double)((2 * n) * (2 * n + 1)))); cs = (1.0 - cs) * (r2 * (1.0 / (double)((2 * n - 1) * (2 * n)))); }
        rs[idx] = (float)(r * (1.0 - sn)); rc[idx] = (float)(1.0 - cs);
    }
}
__device__ __forceinline__ void ln_phase(const Ctx& C, float* Y, const float* g, const float* b, bf16* XB, float* stats, bool final_) {
    const f32x4* g4 = (const f32x4*)g + C.lane; const f32x4* b4 = (const f32x4*)b + C.lane;
    for (int m = C.gw; m < MT; m += C.NGW) {
        f32x4* yr = (f32x4*)(Y + (size_t)m * DM) + C.lane;
        f32x4 v[4]; float s = 0.f;
#pragma unroll
        for (int j = 0; j < 4; ++j) { v[j] = yr[64 * j]; s += (v[j].x + v[j].y) + (v[j].z + v[j].w); }
        const float mean = wave_sum(s) * (1.f / DM); float s2 = 0.f;
#pragma unroll
        for (int j = 0; j < 4; ++j) { const f32x4 d = v[j] - mean; s2 += (d.x * d.x + d.y * d.y) + (d.z * d.z + d.w * d.w); }
        const float rstd = 1.f / sqrtf(wave_sum(s2) * (1.f / DM) + LN_EPS);
        if (final_) {
#pragma unroll
            for (int j = 0; j < 4; ++j) yr[64 * j] = (v[j] - mean) * rstd * g4[64 * j] + b4[64 * j];
        } else {
            if (C.lane == 0) *(f32x2*)(stats + 2 * (size_t)m) = (f32x2){mean, rstd};
            u32x2* o8 = (u32x2*)(XB + (size_t)m * DM) + C.lane;
#pragma unroll
            for (int j = 0; j < 4; ++j) { const f32x4 x = (v[j] - mean) * rstd * g4[64 * j] + b4[64 * j]; o8[64 * j] = (u32x2){pk2(x.x, x.y), pk2(x.z, x.w)}; }
        }
    }
}
__device__ __forceinline__ float logsig(float z) { return fminf(z, 0.f) - log1pf(expf(-fabsf(z))); }
__device__ __forceinline__ void scan_phase(const Ctx& C, const float* __restrict__ flog, const float* __restrict__ bfv, float* __restrict__ nbo) {
    if (C.wave != 0) return;
    for (int bh = C.vcu; bh < NB * 16; bh += C.G) {
        const int bb = bh >> 4, h = bh & 15; const float bias = bfv[h];
        const float* src = flog + ((size_t)bb * SEQ + C.lane) * 16 + h;
        float* dst = nbo + (size_t)bh * SEQ + C.lane;
        double carry = 0.0;
        for (int c0 = 0; c0 < 64; c0 += 16) {
            float v[16];
#pragma unroll
            for (int i = 0; i < 16; ++i) v[i] = src[(size_t)(c0 + i) * 64 * 16];
#pragma unroll
            for (int i = 0; i < 16; ++i) {
                double x = (double)logsig(v[i] + bias);
#pragma unroll
                for (int o = 1; o < 64; o <<= 1) { const double t = __shfl_up(x, o); if (C.lane >= o) x += t; }
                x += carry;
                dst[(c0 + i) * 64] = (float)(-x * 1.4426950408889634);
                carry = __shfl(x, 63);
            }
        }
    }
}
__device__ __forceinline__ void kvpost_phase(const Ctx& C, const float* kvd, const float* kvn, const float* rc, const float* rs, bf16* ckv, bf16* krope) {
    const f32x4 gn = *((const f32x4*)kvn + C.lane);
    for (int m = C.gw; m < MT; m += C.NGW) {
        const float* row = kvd + (size_t)m * 512;
        const f32x4 v = *((const f32x4*)row + C.lane);
        const float ss = wave_sum((v.x * v.x + v.y * v.y) + (v.z * v.z + v.w * v.w));
        const float rr = 1.f / sqrtf(ss * (1.f / 256.f) + RMS_EPS);
        *((u32x2*)(ckv + (size_t)m * 256) + C.lane) = (u32x2){pk2(v.x * rr * gn.x, v.y * rr * gn.y), pk2(v.z * rr * gn.z, v.w * rr * gn.w)};
        if (C.lane < 32) { const int pos = m & (SEQ - 1); const float x1 = row[256 + C.lane], x2 = row[288 + C.lane], c = rc[pos * 32 + C.lane], s = rs[pos * 32 + C.lane];
            *((unsigned*)(krope + (size_t)m * 64) + C.lane) = pk2(x1 * c - x2 * s, x2 * c + x1 * s); }
    }
}
__device__ __forceinline__ void cqpost_phase(const Ctx& C, const float* cq, const float* qn, bf16* cqb) {
    const f32x2 g0 = *((const f32x2*)qn + C.lane), g1 = *((const f32x2*)qn + 64 + C.lane), g2 = *((const f32x2*)qn + 128 + C.lane);
    for (int m = C.gw; m < MT; m += C.NGW) {
        const f32x2* row = (const f32x2*)(cq + (size_t)m * 512) + C.lane;
        const f32x2 a = row[0], b = row[64], c = row[128];
        const float ss = wave_sum((a.x * a.x + a.y * a.y) + (b.x * b.x + b.y * b.y) + (c.x * c.x + c.y * c.y));
        const float rr = 1.f / sqrtf(ss * (1.f / 384.f) + RMS_EPS);
        unsigned* o = (unsigned*)(cqb + (size_t)m * 384) + C.lane;
        o[0] = pk2(a.x * rr * g0.x, a.y * rr * g0.y); o[64] = pk2(b.x * rr * g1.x, b.y * rr * g1.y); o[128] = pk2(c.x * rr * g2.x, c.y * rr * g2.y);
    }
}
template <int OFF_> __device__ __forceinline__ const float* kargb() {
#if defined(__HIP_DEVICE_COMPILE__)
    const auto kp = __builtin_amdgcn_kernarg_segment_ptr(); const float* r;
    asm volatile("s_load_dwordx2 %0, %1, %2\n\ts_waitcnt lgkmcnt(0)" : "=s"(r) : "s"(kp), "i"(OFF_) : "memory"); return r;
#else
    return nullptr;
#endif
}
template <int OFF_> __device__ __forceinline__ int kargi() {
#if defined(__HIP_DEVICE_COMPILE__)
    const auto kp = __builtin_amdgcn_kernarg_segment_ptr(); int r;
    asm volatile("s_load_dword %0, %1, %2\n\ts_waitcnt lgkmcnt(0)" : "=s"(r) : "s"(kp), "i"(OFF_) : "memory"); return r;
#else
    return 0;
#endif
}
template <class Epi> __device__ __forceinline__ void run_gemm(LAS unsigned char* lds, const bf16* A, const bf16* Bt, int M, int N, int K, int G, int bx, const Epi& E) {
    asm volatile("" : "+s"(K));
    pg8::Gemm g{A, Bt, M, N, K}; pg8::StaticOrder S; S.init(M, N, G, bx);
    pg8::gemm_phase<Epi, pg8::StaticOrder, true, true>(lds, g, S, E);
}

__global__ void __launch_bounds__(512, 2) fwd(Args a) {
    __shared__ __attribute__((aligned(16))) unsigned char lds_raw[LDS_BYTES];
    LAS unsigned char* lds = (LAS unsigned char*)lds_raw;
    const int lo = a.lo, hi = a.hi;
#define PH_BEGIN Ctx C; { int bx_ = blockIdx.x; asm volatile("" : "+s"(bx_)); C.tid = threadIdx.x; asm volatile("" : "+v"(C.tid)); C.lane = C.tid & 63; C.wave = __builtin_amdgcn_readfirstlane(C.tid >> 6); C.G = kargi<192>(); \
        C.vcu = (C.G % 8 == 0) ? (bx_ % 8) * (C.G / 8) + bx_ / 8 : bx_; C.gw = C.vcu * 8 + C.wave; C.NGW = C.G * 8; C.lds = lds; C.bx = bx_; } \
        unsigned char* ws = (unsigned char*)kargb<176>(); float* Y = (float*)kargb<168>()
#define KARG(k) kargb<(k) * 8>()
#define x_in KARG(0)
#define p_in KARG(1)
#define ln_g KARG(6)
#define ln_b KARG(7)
#define XB ((bf16*)(ws + WS_XB))
#define H ((bf16*)(ws + WS_H))
#define STATS ((float*)(ws + WS_STATS))
#define RC ((float*)(ws + WS_RCOS))
#define RS ((float*)(ws + WS_RSIN))
#define WFIN(l, f) ((bf16*)(ws + WS_FIN + (size_t)((l) * 2 + (f)) * 11 * MiB))
#define WFOUT(l, f) ((bf16*)(ws + WS_FOUT + (size_t)((l) * 2 + (f)) * 22 * QMiB))
#define WPG(l) ((bf16*)(ws + WS_PG + (size_t)(l) * 2 * MiB))
#define WPP(l) ((bf16*)(ws + WS_PP + (size_t)(l) * 2 * QMiB))
#define LNG(l, k) (ln_g + ((l) * 4 + (k)) * DM)
#define LNB(l, k) (ln_b + ((l) * 4 + (k)) * DM)
#ifndef PHASE_MASK
#define PHASE_MASK 0xffffffffull
#endif
#define IN(k) ((((unsigned long long)PHASE_MASK >> (k)) & 1ull) && lo <= (k) && (k) < hi)
#define SEAM(k) do { if ((k) + 1 < hi) { cg::this_grid().sync(); } } while (0)

    if (IN(0)) { PH_BEGIN;
        for (int l = 0; l < 2; ++l) {
            transpose_mat(C, KARG(2) + (size_t)l * DM * 2 * DFF, DM, 2 * DFF, WFIN(l, 0), 1);
            transpose_mat(C, KARG(4) + (size_t)l * DM * 2 * DFF, DM, 2 * DFF, WFIN(l, 1), 1);
            transpose_mat(C, KARG(3) + (size_t)l * DFF * DM, DFF, DM, WFOUT(l, 0), 0);
            transpose_mat(C, KARG(5) + (size_t)l * DFF * DM, DFF, DM, WFOUT(l, 1), 0);
            transpose_mat(C, KARG(8) + (size_t)l * DM * DM, DM, DM, WPG(l), 0);
            transpose_mat(C, KARG(10) + (size_t)l * PLED * DM, PLED, DM, WPP(l), 0);
        }
        transpose_mat(C, KARG(11), DM, 3088, (bf16*)(ws + WS_FOXIN), 0);
        zero_rows(C, (bf16*)(ws + WS_FOXIN), DM, 3088, 3328);
        transpose_mat(C, KARG(13), DM, DM, (bf16*)(ws + WS_FOXO), 0);
        transpose_mat(C, KARG(14), DM, 384, (bf16*)(ws + WS_DQ), 0);
        zero_rows(C, (bf16*)(ws + WS_DQ), DM, 384, 512);
        transpose_mat(C, KARG(16), 384, 3072, (bf16*)(ws + WS_UQ), 2);
        transpose_mat(C, KARG(17), 2048, DM, (bf16*)(ws + WS_MO), 0);
        transpose_mat(C, KARG(18), DM, 320, (bf16*)(ws + WS_KVD), 0);
        zero_rows(C, (bf16*)(ws + WS_KVD), DM, 320, 512);
        transpose_mat(C, KARG(20), 256, 4096, (bf16*)(ws + WS_KVUP), 0);
        cvt_rows(C, x_in, XB, (size_t)MT * DM);
        rope_tables(C, RC, RS);
        __syncthreads();
        SEAM(0);
    }
#pragma unroll
    for (int l = 0; l < 2; ++l) {
        const int P = 1 + (l == 0 ? 0 : 13);
        if (l == 0) {
            if (IN(1)) { PH_BEGIN; run_gemm(lds, XB, WFIN(0, 0), MT, 2 * DFF, DM, C.G, C.bx, pg8::EpiSwiGLU{H, DFF}); SEAM(1); }
            if (IN(2)) { PH_BEGIN; run_gemm(lds, H, WFOUT(0, 0), MT, DM, DFF, C.G, C.bx, pg8::EpiRes{Y, x_in, STATS, nullptr, nullptr, ALPHA, 0.5f, 0, 0}); SEAM(2); }
            if (IN(3)) { PH_BEGIN; ln_phase(C, Y, LNG(0, 0), LNB(0, 0), XB, STATS, false); SEAM(3); }
#define FQ ((bf16*)(ws + WS_FQ))
#define FK ((bf16*)(ws + WS_FK))
#define FV ((bf16*)(ws + WS_FV))
#define FLOG ((float*)(ws + WS_FLOG))
#define FNB ((float*)(ws + WS_FNB))
            if (IN(4)) { PH_BEGIN; run_gemm(lds, XB, (bf16*)(ws + WS_FOXIN), MT, 3328, DM, C.G, C.bx, pg8::EpiFox{FQ, FK, FV, FLOG, 0.125f * LOG2E}); SEAM(4); }
            if (IN(5)) { PH_BEGIN; scan_phase(C, FLOG, KARG(12), FNB); SEAM(5); }
            if (IN(6)) { PH_BEGIN;
                for (int v = C.vcu; v < 256; v += C.G) { const int bh = v >> 1, s = v & 1, bb = bh >> 4, h = bh & 15; const unsigned base = (unsigned)(((size_t)bb * SEQ * DM + h * 64) * 2);
                    for (int j = 0; j < 8; ++j) { const int gi = j >> 1, qb = (j & 1) ? 4 * gi + 3 - s : 4 * gi + s;
                        att::attn_unit<64, 64, 64, true>(lds, ws, (unsigned)WS_FQ + base, DM, (unsigned)WS_FK + base, DM, 0u, 0, (unsigned)WS_FV + base, DM, (unsigned)WS_FQ + base, DM, FNB + (size_t)bh * SEQ, qb * 256); } }
                SEAM(6);
            }
            if (IN(7)) { PH_BEGIN; run_gemm(lds, FQ, (bf16*)(ws + WS_FOXO), MT, DM, DM, C.G, C.bx, pg8::EpiRes{Y, nullptr, STATS, LNG(0, 0), LNB(0, 0), ALPHA, 1.0f, 1, 0}); SEAM(7); }
            if (IN(8)) { PH_BEGIN; ln_phase(C, Y, LNG(0, 1), LNB(0, 1), XB, STATS, false); SEAM(8); }
        } else {
#define CKV ((bf16*)(ws + WS_CKV))
#define KROPE ((bf16*)(ws + WS_KROPE))
#define CQB ((bf16*)(ws + WS_CQB))
#define KVDF ((float*)(ws + WS_KVDF))
#define CQF ((float*)(ws + WS_CQF))
#define QM ((bf16*)(ws + WS_QM))
#define KN ((bf16*)(ws + WS_KN))
#define VV ((bf16*)(ws + WS_VV))
#define OO ((bf16*)(ws + WS_OO))
            const float qs = 0.07216878364870322f * LOG2E;
            if (IN(14)) { PH_BEGIN; run_gemm(lds, XB, (bf16*)(ws + WS_KVD), MT, 512, DM, C.G, C.bx, pg8::EpiF32{KVDF, 512});
                          run_gemm(lds, XB, WFIN(1, 0), MT, 2 * DFF, DM, C.G, C.bx, pg8::EpiSwiGLU{H, DFF}); SEAM(14); }
            if (IN(15)) { PH_BEGIN; kvpost_phase(C, KVDF, KARG(19), RC, RS, CKV, KROPE);
                          run_gemm(lds, H, WFOUT(1, 0), MT, DM, DFF, C.G, C.bx, pg8::EpiRes{Y, nullptr, STATS, LNG(0, 3), LNB(0, 3), ALPHA, 0.5f, 1, 0}); SEAM(15); }
            if (IN(16)) { PH_BEGIN; ln_phase(C, Y, LNG(1, 0), LNB(1, 0), XB, STATS, false); SEAM(16); }
            if (IN(17)) { PH_BEGIN; run_gemm(lds, XB, (bf16*)(ws + WS_DQ), MT, 512, DM, C.G, C.bx, pg8::EpiF32{CQF, 512}); SEAM(17); }
            if (IN(18)) { PH_BEGIN; cqpost_phase(C, CQF, KARG(15), CQB); SEAM(18); }
#pragma unroll
            for (int hf = 0; hf < 2; ++hf) {
                const int pg = hf == 0 ? 19 : 21, pa = hf == 0 ? 20 : 22;
                if (IN(pg)) { PH_BEGIN;
                    if (hf == 1) run_gemm(lds, OO, (bf16*)(ws + WS_MO), MH, DM, 2048, C.G, C.bx, pg8::EpiRes{Y, nullptr, STATS, LNG(1, 0), LNB(1, 0), ALPHA, 1.0f, 1, 0});
                    run_gemm(lds, CQB + (size_t)hf * MH * 384, (bf16*)(ws + WS_UQ), MH, 3072, 384, C.G, C.bx, pg8::EpiQ{QM, RC, RS, qs});
                    run_gemm(lds, CKV + (size_t)hf * MH * 256, (bf16*)(ws + WS_KVUP), MH, 4096, 256, C.G, C.bx, pg8::EpiKV{KN, VV});
                    SEAM(pg);
                }
                if (IN(pa)) { PH_BEGIN;
                    for (int v = C.vcu; v < 256; v += C.G) { const int bh = v >> 2, s = v & 3, bl = bh >> 4, h = bh & 15; const unsigned lrow = (unsigned)bl * SEQ, grow = (unsigned)(4 * hf + bl) * SEQ;
                        for (int j = 0; j < 4; ++j) { const int gi = j >> 1, qb = (j & 1) ? 8 * gi + 7 - s : 8 * gi + s;
                            att::attn_unit<192, 128, 128, false>(lds, ws, (unsigned)WS_QM + (lrow * 3072 + h * 192) * 2, 3072, (unsigned)WS_KN + (lrow * 2048 + h * 128) * 2, 2048, (unsigned)WS_KROPE + grow * 64 * 2, 64,
                                                                 (unsigned)WS_VV + (lrow * 2048 + h * 128) * 2, 2048, (unsigned)WS_OO + (lrow * 2048 + h * 128) * 2, 2048, nullptr, qb * 256); } }
                    SEAM(pa);
                }
            }
            if (IN(23)) { PH_BEGIN; run_gemm(lds, OO, (bf16*)(ws + WS_MO), MH, DM, 2048, C.G, C.bx, pg8::EpiRes{Y, nullptr, STATS, LNG(1, 0), LNB(1, 0), ALPHA, 1.0f, 1, MH}); SEAM(23); }
            if (IN(24)) { PH_BEGIN; ln_phase(C, Y, LNG(1, 1), LNB(1, 1), XB, STATS, false); SEAM(24); }
        }
        const int Q0 = l == 0 ? 9 : 25;
        if (IN(Q0)) { PH_BEGIN; run_gemm(lds, XB, WFIN(l, 1), MT, 2 * DFF, DM, C.G, C.bx, pg8::EpiSwiGLU{H, DFF}); SEAM(Q0); }
        if (IN(Q0 + 1)) { PH_BEGIN; run_gemm(lds, H, WFOUT(l, 1), MT, DM, DFF, C.G, C.bx, pg8::EpiRes{Y, nullptr, STATS, LNG(l, 1), LNB(l, 1), ALPHA, 0.5f, 1, 0}); SEAM(Q0 + 1); }
        if (IN(Q0 + 2)) { PH_BEGIN; ln_phase(C, Y, LNG(l, 2), LNB(l, 2), XB, STATS, false); cvt_rows(C, p_in + (size_t)l * MT * PLED, (bf16*)(ws + WS_PBF), (size_t)MT * PLED); SEAM(Q0 + 2); }
        if (IN(Q0 + 3)) { PH_BEGIN; bf16* PPA = (bf16*)(ws + WS_PPA);
            run_gemm(lds, (bf16*)(ws + WS_PBF), WPP(l), MT, DM, PLED, C.G, C.bx, pg8::EpiBf16P{PPA, DM});
            run_gemm(lds, XB, WPG(l), MT, DM, DM, C.G, C.bx, pg8::EpiPle{Y, STATS, LNG(l, 2), LNB(l, 2), KARG(9) + l * DM, PPA, ALPHA}); SEAM(Q0 + 3); }
        if (IN(Q0 + 4)) { PH_BEGIN; ln_phase(C, Y, LNG(l, 3), LNB(l, 3), XB, STATS, l == 1); SEAM(Q0 + 4); }
        (void)P;
    }
}

extern "C" void kernel_launch(void* const* d_in, const int* in_sizes, int n_in, void* d_out, int out_size, void* d_ws, size_t ws_size, hipStream_t stream) {
    static int grid = 0;
    if (grid == 0) {
        if (n_in != 21 || out_size != MT * DM || ws_size < WS_END) { fprintf(stderr, "kernel_launch: unexpected shapes: n_in %d out %d ws %zu (need %zu)\n", n_in, out_size, ws_size, (size_t)WS_END); grid = -1; return; }
        int dev = 0, cus = 0;
        if (hipGetDevice(&dev) != hipSuccess || hipDeviceGetAttribute(&cus, hipDeviceAttributeMultiprocessorCount, dev) != hipSuccess) { grid = -1; return; }
        int per_cu = 0;
        if (hipOccupancyMaxActiveBlocksPerMultiprocessor(&per_cu, (const void*)fwd, 512, 0) != hipSuccess || per_cu < 1) fprintf(stderr, "kernel_launch: occupancy query says %d\n", per_cu);
        (void)hipGetLastError();
        grid = cus;
    }
    if (grid < 0) return;
    Args a{};
    for (int i = 0; i < 21; ++i) a.in[i] = (const float*)d_in[i];
    a.out = (float*)d_out; a.ws = (unsigned char*)d_ws; a.G = grid;
#if MULTI_LAUNCH
    for (int ph = 0; ph < NPHASE; ++ph) { a.lo = ph; a.hi = ph + 1; hipLaunchKernelGGL(fwd, dim3(grid), dim3(512), 0, stream, a); }
#else
    a.lo = 0; a.hi = NPHASE;
    void* args[] = {&a};
    hipError_t e = hipLaunchCooperativeKernel((const void*)fwd, dim3(grid), dim3(512), args, 0, stream);
    if (e != hipSuccess) fprintf(stderr, "cooperative launch failed: %s (grid %d)\n", hipGetErrorString(e), grid);
#endif
}
```

```cpp
#include <hip/hip_runtime.h>
#include <hip/hip_cooperative_groups.h>
#include <cstdio>
#include <cstdint>
#include <cmath>
namespace cg = cooperative_groups;
#ifndef MULTI_LAUNCH
#define MULTI_LAUNCH 0
#endif
namespace pg8 {
#define PG8_LAS __attribute__((address_space(3)))
typedef unsigned short bf16_t;
typedef short bf16x8 __attribute__((ext_vector_type(8)));
typedef float f32x4 __attribute__((ext_vector_type(4)));
typedef unsigned u32x4 __attribute__((ext_vector_type(4)));
constexpr int BM = 256, BK = 64, HALF = 128, HTB = HALF * BK * 2  , STAGE_BYTES = 8 * HTB, NXCD = 8, WGM = 8;

__host__ __device__ __forceinline__ int lds_byte(int r, int c) { const int st = (r >> 4) * 2 + (c >> 5), rr = r & 15, cc = c & 31, ob = rr * 64 + cc * 2; return st * 1024 + (ob ^ (((ob >> 9) & 1) << 5)); }
__host__ __device__ __forceinline__ void stage_rc(int b, int& R, int& C) { const int st = b / 1024, sb = b % 1024, swz = sb ^ (((sb >> 9) & 1) << 5); R = (st >> 1) * 16 + swz / 64; C = (st & 1) * 32 + (swz % 64) / 2; }
__host__ __device__ __forceinline__ int perm32(int rho) { const int n = rho >> 4, i = rho & 15; return 8 * (i >> 2) + 4 * n + (i & 3); }

struct Unit { int pm, pn; };
struct Gemm { const bf16_t* A; const bf16_t* Bt; int M, N, K; };

struct StaticOrder {
    int nM, nN, nwg, G, c;
    __host__ __device__ void init(int M, int N, int G_, int c_) { nM = M / BM; nN = N / BM; nwg = nM * nN; G = G_; c = c_; }
    __host__ __device__ bool next(int i, Unit& u) const {
        const long L = (long)i * G + c; if (L >= nwg) return false;
        int wgid = (int)L; { const int q = nwg / NXCD, r = nwg % NXCD, xcd = wgid % NXCD, off = wgid / NXCD; wgid = (xcd < r ? xcd * (q + 1) : r * (q + 1) + (xcd - r) * q) + off; }
        const int nig = WGM * nN, gid = wgid / nig, fm = gid * WGM, gsz = (nM - fm) < WGM ? (nM - fm) : WGM;
        u.pm = fm + ((wgid % nig) % gsz); u.pn = (wgid % nig) / gsz; return true;
    }
    __device__ __forceinline__ void a_ready(const Unit&) const {}
    __device__ __forceinline__ void done(const Unit&) const {}
};
__device__ __forceinline__ unsigned cvt_pk_bf16(float lo, float hi) { unsigned r; asm volatile("v_cvt_pk_bf16_f32 %0, %1, %2" : "=v"(r) : "v"(lo), "v"(hi)); return r; }
typedef float f32x2 __attribute__((ext_vector_type(2)));
typedef unsigned u32x2 __attribute__((ext_vector_type(2)));
__device__ __forceinline__ float silu_f(float g) { return g * __builtin_amdgcn_rcpf(1.0f + __builtin_amdgcn_exp2f(-1.4426950408889634f * g)); }
__device__ __forceinline__ float sigm_f(float g) { return __builtin_amdgcn_rcpf(1.0f + __builtin_amdgcn_exp2f(-1.4426950408889634f * g)); }

struct EpiBf16P {
    static constexpr bool PERM = true, AFTER_DRAIN = false;
    bf16_t* O; int ldc;
    __device__ __forceinline__ void operator()(const f32x4 (&acc)[2][2][4][2], const Unit& u, int wr, int wc, int fr, int fq) const {
        asm volatile("" : "+v"(fr), "+v"(fq));
        const int row0 = u.pm * BM + wr * 64 + fr, col0 = u.pn * BM + wc * 32 + 8 * fq;
#pragma unroll
        for (int ai = 0; ai < 2; ++ai)
#pragma unroll
            for (int m = 0; m < 4; ++m) { bf16_t* rowp = O + (size_t)(row0 + ai * HALF + m * 16) * ldc + col0;
#pragma unroll
                for (int bj = 0; bj < 2; ++bj) { const f32x4 v0 = acc[ai][bj][m][0], v1 = acc[ai][bj][m][1];
                    u32x4 w; w.x = cvt_pk_bf16(v0[0], v0[1]); w.y = cvt_pk_bf16(v0[2], v0[3]); w.z = cvt_pk_bf16(v1[0], v1[1]); w.w = cvt_pk_bf16(v1[2], v1[3]);
                    *(u32x4*)(rowp + bj * HALF) = w; } }
    }
};
struct EpiSwiGLU {
    static constexpr bool PERM = true, AFTER_DRAIN = false;
    bf16_t* H; int ldh;
    __device__ __forceinline__ void operator()(const f32x4 (&acc)[2][2][4][2], const Unit& u, int wr, int wc, int fr, int fq) const {
        asm volatile("" : "+v"(fr), "+v"(fq));
        const int row0 = u.pm * BM + wr * 64 + fr, col0 = u.pn * HALF + wc * 32 + 8 * fq;
#pragma unroll
        for (int ai = 0; ai < 2; ++ai)
#pragma unroll
            for (int m = 0; m < 4; ++m) { bf16_t* rowp = H + (size_t)(row0 + ai * HALF + m * 16) * ldh + col0;
                const f32x4 g0 = acc[ai][0][m][0], g1 = acc[ai][0][m][1], u0 = acc[ai][1][m][0], u1 = acc[ai][1][m][1];
                u32x4 w;
                w.x = cvt_pk_bf16(silu_f(g0[0]) * u0[0], silu_f(g0[1]) * u0[1]); w.y = cvt_pk_bf16(silu_f(g0[2]) * u0[2], silu_f(g0[3]) * u0[3]);
                w.z = cvt_pk_bf16(silu_f(g1[0]) * u1[0], silu_f(g1[1]) * u1[1]); w.w = cvt_pk_bf16(silu_f(g1[2]) * u1[2], silu_f(g1[3]) * u1[3]);
                *(u32x4*)rowp = w; }
    }
};
struct EpiF32 {
    static constexpr bool PERM = false, AFTER_DRAIN = false;
    float* C; int ldc;
    __device__ __forceinline__ void operator()(const f32x4 (&acc)[2][2][4][2], const Unit& u, int wr, int wc, int fr, int fq) const {
        asm volatile("" : "+v"(fr), "+v"(fq));
        const int row0 = u.pm * BM + wr * 64 + fr, col0 = u.pn * BM + wc * 32 + 4 * fq;
#pragma unroll
        for (int ai = 0; ai < 2; ++ai)
#pragma unroll
            for (int m = 0; m < 4; ++m) { float* rowp = C + (size_t)(row0 + ai * HALF + m * 16) * ldc + col0;
#pragma unroll
                for (int bj = 0; bj < 2; ++bj)
#pragma unroll
                    for (int n = 0; n < 2; ++n) *(f32x4*)(rowp + bj * HALF + n * 16) = acc[ai][bj][m][n]; }
    }
};
struct EpiRes {
    static constexpr bool PERM = false, AFTER_DRAIN = false;
    float* Y; const float* Xin; const float* stats; const float* g; const float* b; float alpha, scale; int mode, row_off;
    __device__ __forceinline__ void operator()(const f32x4 (&acc)[2][2][4][2], const Unit& u, int wr, int wc, int fr, int fq) const {
        asm volatile("" : "+v"(fr), "+v"(fq));
        const int row0 = row_off + u.pm * BM + wr * 64 + fr, col0 = u.pn * BM + wc * 32 + 4 * fq;
#pragma unroll
        for (int bj = 0; bj < 2; ++bj)
#pragma unroll
            for (int n = 0; n < 2; ++n) { const int c = col0 + bj * HALF + n * 16;
                f32x4 gv = (f32x4){1.f, 1.f, 1.f, 1.f}, bv = (f32x4){0.f, 0.f, 0.f, 0.f};
                if (mode) { gv = *(const f32x4*)(g + c); bv = *(const f32x4*)(b + c); }
#pragma unroll
                for (int ai = 0; ai < 2; ++ai)
#pragma unroll
                    for (int m = 0; m < 4; ++m) { const int r = row0 + ai * HALF + m * 16; const size_t off = (size_t)r * 1024 + c;
                        f32x4 xo;
                        if (mode) { const f32x2 st = *(const f32x2*)(stats + 2 * (size_t)r); const f32x4 yo = *(const f32x4*)(Y + off); xo = (yo - st.x) * st.y * gv + bv; }
                        else xo = *(const f32x4*)(Xin + off);
                        *(f32x4*)(Y + off) = xo * alpha + acc[ai][bj][m][n] * scale; } }
    }
};
struct EpiPle {
    static constexpr bool PERM = true, AFTER_DRAIN = false;
    float* Y; const float* stats; const float* g; const float* b; const float* bg; const bf16_t* PP; float alpha;
    __device__ __forceinline__ void operator()(const f32x4 (&acc)[2][2][4][2], const Unit& u, int wr, int wc, int fr, int fq) const {
        asm volatile("" : "+v"(fr), "+v"(fq));
        const int row0 = u.pm * BM + wr * 64 + fr, col0 = u.pn * BM + wc * 32 + 8 * fq;
#pragma unroll
        for (int bj = 0; bj < 2; ++bj) { const int c = col0 + bj * HALF;
            const f32x4 g0 = *(const f32x4*)(g + c), g1 = *(const f32x4*)(g + c + 4), b0 = *(const f32x4*)(b + c), b1 = *(const f32x4*)(b + c + 4);
            const f32x4 q0 = *(const f32x4*)(bg + c), q1 = *(const f32x4*)(bg + c + 4);
#pragma unroll
            for (int ai = 0; ai < 2; ++ai)
#pragma unroll
                for (int m = 0; m < 4; ++m) { const int r = row0 + ai * HALF + m * 16; const size_t off = (size_t)r * 1024 + c;
                    const f32x2 st = *(const f32x2*)(stats + 2 * (size_t)r);
                    const f32x4 y0 = *(const f32x4*)(Y + off), y1 = *(const f32x4*)(Y + off + 4);
                    const u32x4 pw = *(const u32x4*)(PP + off);
                    const f32x4 x0 = (y0 - st.x) * st.y * g0 + b0, x1 = (y1 - st.x) * st.y * g1 + b1;
                    const f32x4 a0 = acc[ai][bj][m][0] + q0, a1 = acc[ai][bj][m][1] + q1;
                    f32x4 p0, p1;
                    p0[0] = __uint_as_float(pw.x << 16); p0[1] = __uint_as_float(pw.x & 0xffff0000u); p0[2] = __uint_as_float(pw.y << 16); p0[3] = __uint_as_float(pw.y & 0xffff0000u);
                    p1[0] = __uint_as_float(pw.z << 16); p1[1] = __uint_as_float(pw.z & 0xffff0000u); p1[2] = __uint_as_float(pw.w << 16); p1[3] = __uint_as_float(pw.w & 0xffff0000u);
                    f32x4 o0, o1;
#pragma unroll
                    for (int e = 0; e < 4; ++e) { o0[e] = x0[e] * alpha + sigm_f(a0[e]) * p0[e]; o1[e] = x1[e] * alpha + sigm_f(a1[e]) * p1[e]; }
                    *(f32x4*)(Y + off) = o0; *(f32x4*)(Y + off + 4) = o1; asm volatile("" ::: "memory"); } }
    }
};
struct EpiFox {
    static constexpr bool PERM = true, AFTER_DRAIN = false;
    bf16_t* Q; bf16_t* K; bf16_t* V; float* flog; float qscale;
    __device__ __forceinline__ void operator()(const f32x4 (&acc)[2][2][4][2], const Unit& u, int wr, int wc, int fr, int fq) const {
        asm volatile("" : "+v"(fr), "+v"(fq));
        const int row0 = u.pm * BM + wr * 64 + fr;
        if (u.pn == 12) {
            if (wc == 0 && fq < 2) {
#pragma unroll
                for (int ai = 0; ai < 2; ++ai)
#pragma unroll
                    for (int m = 0; m < 4; ++m) { float* p = flog + (size_t)(row0 + ai * HALF + m * 16) * 16 + 8 * fq;
                        *(f32x4*)p = acc[ai][0][m][0]; *(f32x4*)(p + 4) = acc[ai][0][m][1]; }
            }
            return;
        }
        const int t = u.pn >> 2; bf16_t* base = Q + (size_t)t * ((size_t)64 << 19); const float sc = t == 0 ? qscale : 1.0f;
        const int col0 = (u.pn & 3) * BM + wc * 32 + 8 * fq;
#pragma unroll
        for (int ai = 0; ai < 2; ++ai)
#pragma unroll
            for (int m = 0; m < 4; ++m) { bf16_t* rowp = base + (size_t)(row0 + ai * HALF + m * 16) * 1024 + col0;
#pragma unroll
                for (int bj = 0; bj < 2; ++bj) { const f32x4 v0 = acc[ai][bj][m][0] * sc, v1 = acc[ai][bj][m][1] * sc;
                    u32x4 w; w.x = cvt_pk_bf16(v0[0], v0[1]); w.y = cvt_pk_bf16(v0[2], v0[3]); w.z = cvt_pk_bf16(v1[0], v1[1]); w.w = cvt_pk_bf16(v1[2], v1[3]);
                    *(u32x4*)(rowp + bj * HALF) = w; } }
    }
};
struct EpiQ {
    static constexpr bool PERM = true, AFTER_DRAIN = false;
    bf16_t* QM; const float* rcos; const float* rsin; float qscale;
    __device__ __forceinline__ void operator()(const f32x4 (&acc)[2][2][4][2], const Unit& u, int wr, int wc, int fr, int fq) const {
        asm volatile("" : "+v"(fr), "+v"(fq));
        const int row0 = u.pm * BM + wr * 64 + fr, col0 = u.pn * BM + wc * 32 + 8 * fq;
#pragma unroll
        for (int bj = 0; bj < 2; ++bj) { const int c = col0 + bj * HALF; const int w0 = c % 192; const bool rp = w0 >= 128; const int i0 = rp ? (w0 - 128) >> 1 : 0;
#pragma unroll
            for (int ai = 0; ai < 2; ++ai)
#pragma unroll
                for (int m = 0; m < 4; ++m) { const int r = row0 + ai * HALF + m * 16;
                    f32x4 v0 = acc[ai][bj][m][0], v1 = acc[ai][bj][m][1];
                    if (rp) { const int pos = r & 4095; const f32x4 cs = *(const f32x4*)(rcos + pos * 32 + i0), sn = *(const f32x4*)(rsin + pos * 32 + i0);
                        f32x4 t0, t1;
                        t0[0] = v0[0] * cs[0] - v0[1] * sn[0]; t0[1] = v0[1] * cs[0] + v0[0] * sn[0]; t0[2] = v0[2] * cs[1] - v0[3] * sn[1]; t0[3] = v0[3] * cs[1] + v0[2] * sn[1];
                        t1[0] = v1[0] * cs[2] - v1[1] * sn[2]; t1[1] = v1[1] * cs[2] + v1[0] * sn[2]; t1[2] = v1[2] * cs[3] - v1[3] * sn[3]; t1[3] = v1[3] * cs[3] + v1[2] * sn[3];
                        v0 = t0; v1 = t1; }
                    v0 = v0 * qscale; v1 = v1 * qscale;
                    u32x4 w; w.x = cvt_pk_bf16(v0[0], v0[1]); w.y = cvt_pk_bf16(v0[2], v0[3]); w.z = cvt_pk_bf16(v1[0], v1[1]); w.w = cvt_pk_bf16(v1[2], v1[3]);
                    *(u32x4*)(QM + (size_t)r * 3072 + c) = w; asm volatile("" ::: "memory"); } }
    }
};
struct EpiKV {
    static constexpr bool PERM = true, AFTER_DRAIN = false;
    bf16_t* KN; bf16_t* VV;
    __device__ __forceinline__ void operator()(const f32x4 (&acc)[2][2][4][2], const Unit& u, int wr, int wc, int fr, int fq) const {
        asm volatile("" : "+v"(fr), "+v"(fq));
        const int row0 = u.pm * BM + wr * 64 + fr, col0 = u.pn * HALF + wc * 32 + 8 * fq;
#pragma unroll
        for (int ai = 0; ai < 2; ++ai)
#pragma unroll
            for (int m = 0; m < 4; ++m) { const size_t off = (size_t)(row0 + ai * HALF + m * 16) * 2048 + col0;
#pragma unroll
                for (int bj = 0; bj < 2; ++bj) { const f32x4 v0 = acc[ai][bj][m][0], v1 = acc[ai][bj][m][1];
                    u32x4 w; w.x = cvt_pk_bf16(v0[0], v0[1]); w.y = cvt_pk_bf16(v0[2], v0[3]); w.z = cvt_pk_bf16(v1[0], v1[1]); w.w = cvt_pk_bf16(v1[2], v1[3]);
                    *(u32x4*)((bj == 0 ? KN : VV) + off) = w; } }
    }
};
template <class Epi, class Sched, bool ALIGN_EPI = false, bool SP2 = false>
__device__ __forceinline__ void gemm_phase(PG8_LAS unsigned char* lds, const Gemm g, const Sched& S, const Epi& E) {
    int tid_ = threadIdx.x; asm volatile("" : "+v"(tid_));
    const int tid = tid_, wid = __builtin_amdgcn_readfirstlane(tid >> 6), lane = tid & 63, wr = wid >> 2, wc = wid & 3, fr = lane & 15, fq = lane >> 4;
    const int K = g.K, nt = K / BK;
    unsigned voffA[2], voffB[2];
#pragma unroll
    for (int i = 0; i < 2; ++i) { int R, C; stage_rc(tid * 16 + i * 8192, R, C); const int Rb = Epi::PERM ? ((R & ~31) + perm32(R & 31)) : R;
        voffA[i] = (unsigned)(R * K + C) * 2u; voffB[i] = (unsigned)(Rb * K + C) * 2u; }
    const size_t kstep = (size_t)(BK * 2);
    const size_t hstep = (size_t)HALF * K * 2;
    const size_t tstep = 2 * hstep;
    const unsigned ldsw = (unsigned)wid * 1024u;
    const int aoff = lds_byte(wr * 64 + fr, fq * 8), boff = lds_byte(wc * 32 + fr, fq * 8);
#define PG8_SA(b, h) (((b) * 2 + (h)) * HTB)
#define PG8_SB(b, h) ((4 + (b) * 2 + (h)) * HTB)
#define PG8_STAGE(bufoff, gbase, voff) do { _Pragma("unroll") for (int _i = 0; _i < 2; ++_i) \
        __builtin_amdgcn_global_load_lds((const unsigned*)((const char*)(gbase) + (voff)[_i]), (PG8_LAS unsigned*)(lds + (bufoff) + ldsw + _i * 8192), 16, 0, 0); } while (0)
#define PG8_LDA(dst, b, h) do { _Pragma("unroll") for (int m = 0; m < 4; ++m) _Pragma("unroll") for (int k = 0; k < 2; ++k) dst[m][k] = *(const PG8_LAS bf16x8*)(lds + PG8_SA(b, h) + aoff + m * 2048 + k * 1024); } while (0)
#define PG8_LDB(dst, b, h) do { _Pragma("unroll") for (int n = 0; n < 2; ++n) _Pragma("unroll") for (int k = 0; k < 2; ++k) dst[n][k] = *(const PG8_LAS bf16x8*)(lds + PG8_SB(b, h) + boff + n * 2048 + k * 1024); } while (0)
#define PG8_MMA(ai, bj, At, Bt) do { __builtin_amdgcn_s_setprio(1); _Pragma("unroll") for (int m = 0; m < 4; ++m) _Pragma("unroll") for (int n = 0; n < 2; ++n) _Pragma("unroll") for (int k = 0; k < 2; ++k) \
        acc[ai][bj][m][n] = __builtin_amdgcn_mfma_f32_16x16x32_bf16(Bt[n][k], At[m][k], acc[ai][bj][m][n], 0, 0, 0); __builtin_amdgcn_s_setprio(0); } while (0)
#define PG8_WAIT_V(n) asm volatile("s_waitcnt vmcnt(" #n ")" ::: "memory")
#define PG8_WAIT_L(n) asm volatile("s_waitcnt lgkmcnt(" #n ")" ::: "memory")
#define PG8_BAR __builtin_amdgcn_s_barrier()
#define PG8_SCHED __builtin_amdgcn_sched_barrier(0)
    Unit cur, nxt; int ui = 0;
    if (!S.next(0, cur)) return;
    f32x4 acc[2][2][4][2];
#pragma unroll
    for (int a = 0; a < 2; ++a)
#pragma unroll
        for (int b = 0; b < 2; ++b)
#pragma unroll
            for (int m = 0; m < 4; ++m)
#pragma unroll
                for (int n = 0; n < 2; ++n) acc[a][b][m][n] = (f32x4){0.f, 0.f, 0.f, 0.f};
    bf16x8 At[4][2], B0[2][2], B1[2][2];
    const char* cA = (const char*)g.A + (size_t)cur.pm * tstep; const char* cB = (const char*)g.Bt + (size_t)cur.pn * tstep;
    S.a_ready(cur);
    if constexpr (SP2) {
        PG8_STAGE(PG8_SB(0, 0), cB, voffB); PG8_STAGE(PG8_SB(0, 1), cB + hstep, voffB); PG8_STAGE(PG8_SA(0, 0), cA, voffA); PG8_STAGE(PG8_SA(0, 1), cA + hstep, voffA);
        if (wr == 1) PG8_BAR;
        PG8_WAIT_V(2); PG8_BAR;
        PG8_STAGE(PG8_SB(1, 0), cB + kstep, voffB); PG8_STAGE(PG8_SA(1, 0), cA + kstep, voffA); PG8_STAGE(PG8_SB(1, 1), cB + hstep + kstep, voffB);
        PG8_WAIT_V(6); PG8_BAR;
    } else {
        PG8_STAGE(PG8_SB(0, 0), cB, voffB); PG8_STAGE(PG8_SA(0, 0), cA, voffA); PG8_STAGE(PG8_SB(0, 1), cB + hstep, voffB); PG8_STAGE(PG8_SA(0, 1), cA + hstep, voffA);
        if (wr == 1) PG8_BAR;
        PG8_WAIT_V(4); PG8_BAR;
        PG8_STAGE(PG8_SB(1, 0), cB + kstep, voffB); PG8_STAGE(PG8_SA(1, 0), cA + kstep, voffA); PG8_STAGE(PG8_SB(1, 1), cB + hstep + kstep, voffB);
        PG8_WAIT_V(6); PG8_BAR;
    }
    for (;;) {
        const bool has_next = S.next(ui + 1, nxt);
        const char* nA = has_next ? (const char*)g.A + (size_t)nxt.pm * tstep : cA; const char* nB = has_next ? (const char*)g.Bt + (size_t)nxt.pn * tstep : cB;
        for (int t = 0; t < nt; t += 2) {
            const bool last = (t == nt - 2);
            const char* a1 = cA + (size_t)(t + 1) * kstep;
            const char* a2 = last ? nA : cA + (size_t)(t + 2) * kstep; const char* b2 = last ? nB : cB + (size_t)(t + 2) * kstep;
            const char* a3 = a2 + kstep; const char* b3 = b2 + kstep;
            if (last && has_next) S.a_ready(nxt);
            if constexpr (SP2) {
            PG8_LDB(B0, 0, 0); PG8_LDB(B1, 0, 1); PG8_SCHED; PG8_LDA(At, 0, 0); PG8_STAGE(PG8_SA(1, 1), a1 + hstep, voffA);
            PG8_WAIT_V(8); PG8_WAIT_L(0); PG8_BAR; PG8_MMA(0, 0, At, B0); PG8_MMA(0, 1, At, B1); PG8_BAR; PG8_SCHED;
            PG8_LDA(At, 0, 1); PG8_STAGE(PG8_SB(0, 0), b2, voffB); PG8_STAGE(PG8_SB(0, 1), b2 + hstep, voffB); PG8_STAGE(PG8_SA(0, 0), a2, voffA);
            PG8_WAIT_V(8); PG8_WAIT_L(0); PG8_BAR; PG8_MMA(1, 0, At, B0); PG8_MMA(1, 1, At, B1); PG8_BAR; PG8_SCHED;
            PG8_LDB(B0, 1, 0); PG8_LDB(B1, 1, 1); PG8_SCHED; PG8_LDA(At, 1, 0); PG8_STAGE(PG8_SA(0, 1), a2 + hstep, voffA);
            PG8_WAIT_V(8); PG8_WAIT_L(0); PG8_BAR; PG8_MMA(0, 0, At, B0); PG8_MMA(0, 1, At, B1); PG8_BAR; PG8_SCHED;
            PG8_LDA(At, 1, 1); PG8_STAGE(PG8_SB(1, 0), b3, voffB); PG8_STAGE(PG8_SB(1, 1), b3 + hstep, voffB); PG8_STAGE(PG8_SA(1, 0), a3, voffA);
            PG8_WAIT_V(8); PG8_WAIT_L(0); PG8_BAR; PG8_MMA(1, 0, At, B0); PG8_MMA(1, 1, At, B1); PG8_BAR; PG8_SCHED;
            } else {
            PG8_LDB(B0, 0, 0); PG8_SCHED; PG8_LDA(At, 0, 0); PG8_STAGE(PG8_SA(1, 1), a1 + hstep, voffA);
            PG8_WAIT_L(8); PG8_BAR; PG8_WAIT_L(0); PG8_MMA(0, 0, At, B0); PG8_BAR; PG8_SCHED;
            PG8_LDB(B1, 0, 1); PG8_STAGE(PG8_SB(0, 0), b2, voffB);
            PG8_BAR; PG8_WAIT_L(0); PG8_MMA(0, 1, At, B1); PG8_BAR;
            PG8_LDA(At, 0, 1); PG8_STAGE(PG8_SA(0, 0), a2, voffA);
            PG8_BAR; PG8_WAIT_L(0); PG8_MMA(1, 0, At, B0); PG8_BAR; PG8_SCHED;
            PG8_STAGE(PG8_SB(0, 1), b2 + hstep, voffB);
            PG8_WAIT_V(6); PG8_BAR; PG8_MMA(1, 1, At, B1); PG8_BAR;
            PG8_LDB(B0, 1, 0); PG8_SCHED; PG8_LDA(At, 1, 0); PG8_STAGE(PG8_SA(0, 1), a2 + hstep, voffA);
            PG8_WAIT_L(8); PG8_BAR; PG8_WAIT_L(0); PG8_MMA(0, 0, At, B0); PG8_BAR; PG8_SCHED;
            PG8_LDB(B1, 1, 1); PG8_STAGE(PG8_SB(1, 0), b3, voffB);
            PG8_BAR; PG8_WAIT_L(0); PG8_MMA(0, 1, At, B1); PG8_BAR;
            PG8_LDA(At, 1, 1); PG8_STAGE(PG8_SA(1, 0), a3, voffA);
            PG8_BAR; PG8_WAIT_L(0); PG8_MMA(1, 0, At, B0); PG8_BAR; PG8_SCHED;
            PG8_STAGE(PG8_SB(1, 1), b3 + hstep, voffB);
            PG8_WAIT_V(6); PG8_BAR; PG8_MMA(1, 1, At, B1); PG8_BAR;
            }
        }
        if constexpr (ALIGN_EPI) { if (wr == 0) PG8_BAR; }
        if constexpr (!Epi::AFTER_DRAIN) { E(acc, cur, wr, wc, fr, fq); S.done(cur); }
        if (!has_next) break;
#pragma unroll
        for (int a = 0; a < 2; ++a)
#pragma unroll
            for (int b = 0; b < 2; ++b)
#pragma unroll
                for (int m = 0; m < 4; ++m)
#pragma unroll
                    for (int n = 0; n < 2; ++n) acc[a][b][m][n] = (f32x4){0.f, 0.f, 0.f, 0.f};
        cur = nxt; cA = nA; cB = nB; ++ui;
        if constexpr (ALIGN_EPI) { if (wr == 1) PG8_BAR; }
    }
    PG8_WAIT_V(0);
    if constexpr (!ALIGN_EPI) { if (wr == 0) PG8_BAR; }
    PG8_BAR;
    if constexpr (Epi::AFTER_DRAIN) { E.fused(acc, cur, wr, wc, fr, fq, lds, wid, lane); S.done(cur); }
#undef PG8_SA
#undef PG8_SB
#undef PG8_STAGE
#undef PG8_LDA
#undef PG8_LDB
#undef PG8_MMA
#undef PG8_WAIT_V
#undef PG8_WAIT_L
#undef PG8_BAR
#undef PG8_SCHED
}
}
namespace att {
#define ALAS __attribute__((address_space(3)))
typedef unsigned short bf16_t;
typedef short bf16x8 __attribute__((ext_vector_type(8)));
typedef short s16x4 __attribute__((ext_vector_type(4)));
typedef float f32x16 __attribute__((ext_vector_type(16)));
typedef float f32x4 __attribute__((ext_vector_type(4)));
typedef unsigned u32x4 __attribute__((ext_vector_type(4)));
typedef unsigned u32x2 __attribute__((ext_vector_type(2)));
typedef float f32x2_t __attribute__((ext_vector_type(2))); typedef __bf16 bf16x2_t __attribute__((ext_vector_type(2)));
__device__ __forceinline__ unsigned cvtpk(float lo, float hi) { f32x2_t v = {lo, hi}; bf16x2_t b = __builtin_convertvector(v, bf16x2_t); return __builtin_bit_cast(unsigned, b); }
__device__ __forceinline__ s16x4 vtr(const ALAS unsigned char* p) { return __builtin_bit_cast(s16x4, __builtin_amdgcn_ds_read_tr16_b64_v4i16((ALAS s16x4*)p)); }

template <int DQK, int DN, int DV, bool BIAS>
__device__ __forceinline__ void attn_unit(ALAS unsigned char* lds, const unsigned char* wsb, unsigned qoff, int qp, unsigned knoff, int knp, unsigned kroff, int krp,
                                          unsigned voff, int vp, unsigned ooff, int op, const float* nb, int q0) {
    constexpr int KP = DQK * 2 + 16, KBUF = 64 * KP, VBUF = 64 * DV * 2, OFF_V = 2 * KBUF, OFF_B = OFF_V + 2 * VBUF;
    constexpr int NKN = DN / 64, NKR = (DQK - DN) / 64, NVC = DV / 64, NST = DQK / 16, NDB = DV / 32;
    int tid_ = threadIdx.x; asm volatile("" : "+v"(tid_));
    const int tid = tid_, lane = tid & 63, r32 = lane & 31, hi = lane >> 5; const int wid = __builtin_amdgcn_readfirstlane(tid >> 6);
    const int NT = (q0 + 256) / 64;
    const int qrow = q0 + 32 * wid + r32, qmin = q0 + 32 * wid, qmax = qmin + 31;
    const int skey = tid >> 3, sc = tid & 7;
    const unsigned lkn = (unsigned)(skey * knp * 2 + sc * 16), lkr = (unsigned)(skey * krp * 2 + sc * 16), lv = (unsigned)(skey * vp * 2 + sc * 16);
    const unsigned tkn = 64u * (unsigned)knp * 2u, tkr = 64u * (unsigned)krp * 2u, tv = 64u * (unsigned)vp * 2u;
    u32x4 kreg[NKN + NKR], vreg[NVC]; f32x4 breg = (f32x4){0.f, 0.f, 0.f, 0.f};
#define ATT_LOADK(t) do { \
    _Pragma("unroll") for (int i_ = 0; i_ < NKN; ++i_) kreg[i_] = *(const u32x4*)(wsb + (size_t)(knoff + (unsigned)(t) * tkn + lkn) + i_ * 128); \
    _Pragma("unroll") for (int i_ = 0; i_ < NKR; ++i_) kreg[NKN + i_] = *(const u32x4*)(wsb + (size_t)(kroff + (unsigned)(t) * tkr + lkr) + i_ * 128); \
    if (BIAS) { if (tid < 16) breg = *(const f32x4*)(nb + 64 * (t) + 4 * tid); } } while (0)
#define ATT_LOADV(t) do { \
    _Pragma("unroll") for (int i_ = 0; i_ < NVC; ++i_) vreg[i_] = *(const u32x4*)(wsb + (size_t)(voff + (unsigned)(t) * tv + lv) + i_ * 128); } while (0)
#define ATT_STORE(buf) do { \
    _Pragma("unroll") for (int i_ = 0; i_ < NKN + NKR; ++i_) *(ALAS u32x4*)(lds + (buf) * KBUF + skey * KP + sc * 16 + i_ * 128) = kreg[i_]; \
    _Pragma("unroll") for (int i_ = 0; i_ < NVC; ++i_) *(ALAS u32x4*)(lds + OFF_V + (buf) * VBUF + (2 * i_ + (sc >> 2)) * 4096 + skey * 64 + (sc & 3) * 16) = vreg[i_]; \
    if (BIAS) { if (tid < 16) *(ALAS f32x4*)(lds + OFF_B + (buf) * 256 + tid * 16) = breg; } } while (0)
    ATT_LOADK(0); ATT_LOADV(0);
    bf16x8 qr[NST];
#pragma unroll
    for (int st = 0; st < NST; ++st) qr[st] = *(const bf16x8*)(wsb + (size_t)(qoff + (unsigned)(qrow * qp * 2 + 16 * hi)) + 32 * st);
    f32x16 o[NDB];
#pragma unroll
    for (int db = 0; db < NDB; ++db)
#pragma unroll
        for (int r = 0; r < 16; ++r) o[db][r] = 0.f;
    float mrun = -INFINITY, lrun = 0.f;
    ATT_STORE(0);
    __syncthreads();
    for (int t = 0; t < NT; ++t) {
        const int buf = t & 1;
        if (t + 1 < NT) ATT_LOADK(t + 1);
        if (64 * t <= qmax) {
            const ALAS unsigned char* kb = lds + buf * KBUF + r32 * KP + hi * 16;
            f32x16 p0, p1;
#pragma unroll
            for (int r = 0; r < 16; ++r) { p0[r] = 0.f; p1[r] = 0.f; }
#pragma unroll
            for (int st = 0; st < NST; ++st) {
                const bf16x8 k0 = *(const ALAS bf16x8*)(kb + st * 32), k1 = *(const ALAS bf16x8*)(kb + 32 * KP + st * 32);
                p0 = __builtin_amdgcn_mfma_f32_32x32x16_bf16(k0, qr[st], p0, 0, 0, 0);
                p1 = __builtin_amdgcn_mfma_f32_32x32x16_bf16(k1, qr[st], p1, 0, 0, 0);
            }
            if (BIAS) {
                const ALAS float* bb = (const ALAS float*)(lds + OFF_B + buf * 256);
#pragma unroll
                for (int g = 0; g < 4; ++g) { const f32x4 b0 = *(const ALAS f32x4*)(bb + 8 * g + 4 * hi), b1 = *(const ALAS f32x4*)(bb + 32 + 8 * g + 4 * hi);
#pragma unroll
                    for (int e = 0; e < 4; ++e) { p0[4 * g + e] += b0[e]; p1[4 * g + e] += b1[e]; } }
            }
            if (64 * t + 63 > qmin) {
#pragma unroll
                for (int r = 0; r < 16; ++r) { const int key = 64 * t + (r & 3) + 8 * (r >> 2) + 4 * hi;
                    if (key > qrow) p0[r] = -INFINITY; if (key + 32 > qrow) p1[r] = -INFINITY; }
            }
            float mx = fmaxf(p0[0], p1[0]);
#pragma unroll
            for (int r = 1; r < 16; ++r) mx = fmaxf(mx, fmaxf(p0[r], p1[r]));
            mx = fmaxf(mx, __shfl_xor(mx, 32));
            const float mn = fmaxf(mrun, mx), al = __builtin_amdgcn_exp2f(mrun - mn);
            mrun = mn;
            float sum = 0.f;
#pragma unroll
            for (int r = 0; r < 16; ++r) { p0[r] = __builtin_amdgcn_exp2f(p0[r] - mn); p1[r] = __builtin_amdgcn_exp2f(p1[r] - mn); sum += p0[r] + p1[r]; }
            lrun = lrun * al + sum;
            if (__any(al != 1.0f)) {
#pragma unroll
                for (int db = 0; db < NDB; ++db)
#pragma unroll
                    for (int r = 0; r < 16; ++r) o[db][r] *= al;
            }
            u32x4 pw[4];
#pragma unroll
            for (int s = 0; s < 2; ++s) {
                pw[s] = (u32x4){cvtpk(p0[8 * s], p0[8 * s + 1]), cvtpk(p0[8 * s + 2], p0[8 * s + 3]), cvtpk(p0[8 * s + 4], p0[8 * s + 5]), cvtpk(p0[8 * s + 6], p0[8 * s + 7])};
                pw[2 + s] = (u32x4){cvtpk(p1[8 * s], p1[8 * s + 1]), cvtpk(p1[8 * s + 2], p1[8 * s + 3]), cvtpk(p1[8 * s + 4], p1[8 * s + 5]), cvtpk(p1[8 * s + 6], p1[8 * s + 7])};
            }
            __builtin_amdgcn_sched_barrier(0);
            if (t + 1 < NT) ATT_LOADV(t + 1);
            const ALAS unsigned char* vb = lds + OFF_V + buf * VBUF + ((lane >> 4) & 1) * 32 + (lane & 3) * 8 + (4 * hi + ((lane & 15) >> 2)) * 64;
#pragma unroll
            for (int db = 0; db < NDB; ++db)
#pragma unroll
                for (int s = 0; s < 4; ++s) {
                    const s16x4 lo = vtr(vb + db * 4096 + s * 1024), hh = vtr(vb + db * 4096 + s * 1024 + 512);
                    const bf16x8 vf = (bf16x8){lo[0], lo[1], lo[2], lo[3], hh[0], hh[1], hh[2], hh[3]};
                    o[db] = __builtin_amdgcn_mfma_f32_32x32x16_bf16(vf, __builtin_bit_cast(bf16x8, pw[s]), o[db], 0, 0, 0);
                    if (s == 3) __builtin_amdgcn_sched_barrier(0);
                }
        }
        if (t + 1 < NT) { if (64 * t > qmax) ATT_LOADV(t + 1); ATT_STORE(buf ^ 1); }
        __syncthreads();
    }
    const float lt = lrun + __shfl_xor(lrun, 32), inv = 1.0f / lt;
    bf16_t* orow = (bf16_t*)(const_cast<unsigned char*>(wsb) + (size_t)(ooff + (unsigned)(qrow * op * 2 + 8 * hi)));
#pragma unroll
    for (int db = 0; db < NDB; ++db)
#pragma unroll
        for (int g = 0; g < 4; ++g) { u32x2 w; w.x = cvtpk(o[db][4 * g] * inv, o[db][4 * g + 1] * inv); w.y = cvtpk(o[db][4 * g + 2] * inv, o[db][4 * g + 3] * inv);
            *(u32x2*)(orow + 32 * db + 8 * g) = w; }
#undef ATT_LOADK
#undef ATT_LOADV
#undef ATT_STORE
}
}
#define LAS __attribute__((address_space(3)))
typedef unsigned short bf16;
typedef float f32x4 __attribute__((ext_vector_type(4)));
typedef float f32x2 __attribute__((ext_vector_type(2)));
typedef unsigned u32x4 __attribute__((ext_vector_type(4)));
typedef unsigned u32x2 __attribute__((ext_vector_type(2)));
constexpr int NB = 8, SEQ = 4096, DM = 1024, MT = NB * SEQ, DFF = 2816, PLED = 256, MH = MT / 2;
constexpr float ALPHA = 1.4142135623730951f, LN_EPS = 1e-5f, RMS_EPS = 1e-6f, LOG2E = 1.4426950408889634f;
constexpr size_t MiB = 1u << 20, QMiB = 1u << 18;
constexpr size_t WS_FIN = 0;
constexpr size_t WS_FOUT = 44 * MiB;
constexpr size_t WS_PG = 66 * MiB;
constexpr size_t WS_PP = 70 * MiB;
constexpr size_t WS_FOXIN = 71 * MiB;
constexpr size_t WS_FOXO = 71 * MiB + 26 * QMiB;
constexpr size_t WS_DQ = WS_FOXO + 2 * MiB;
constexpr size_t WS_UQ = WS_DQ + 1 * MiB;
constexpr size_t WS_MO = WS_UQ + 9 * QMiB;
constexpr size_t WS_KVD = WS_MO + 4 * MiB;
constexpr size_t WS_KVUP = WS_KVD + 1 * MiB;
constexpr size_t WS_RCOS = 90 * MiB, WS_RSIN = 90 * MiB + 2 * QMiB;
constexpr size_t WS_STATS = 91 * MiB;
constexpr size_t WS_CTL = 91 * MiB + 2 * QMiB;
constexpr size_t CTL_BYTES = 64 * 1024;
constexpr size_t WS_XB = 92 * MiB;
constexpr size_t WS_CKV = 156 * MiB;
constexpr size_t WS_KROPE = 172 * MiB;
constexpr size_t WS_CQB = 176 * MiB;
constexpr size_t WS_R = 200 * MiB;
constexpr size_t WS_H = WS_R;
constexpr size_t WS_KVDF = WS_R + 176 * MiB;
constexpr size_t WS_FQ = WS_R, WS_FK = WS_R + 64 * MiB, WS_FV = WS_R + 128 * MiB, WS_FLOG = WS_R + 192 * MiB, WS_FNB = WS_R + 194 * MiB;
constexpr size_t WS_PBF = WS_R, WS_PPA = WS_R + 16 * MiB;
constexpr size_t WS_CQF = WS_R;
constexpr size_t WS_QM = WS_R, WS_KN = WS_R + 96 * MiB, WS_VV = WS_R + 160 * MiB, WS_OO = WS_R + 224 * MiB;
constexpr size_t WS_END = 512 * MiB;
static_assert(WS_KVUP + 2 * MiB <= WS_RCOS && WS_OO + 64 * MiB <= WS_END && WS_KVDF + 64 * MiB <= WS_END, "ws map");

constexpr int LDS_BYTES = 147456, LDS_BAR_OFF = 131072 + 1024;
constexpr int NPHASE = 30;

struct Args { const float* in[21]; float* out; unsigned char* ws; int lo, hi, G, pad; };
static_assert(sizeof(Args) == 200, "Args layout");
__device__ const double ROPE_INV[32] = {1.0, 0.7498942093324559, 0.5623413251903491, 0.4216965034285822, 0.31622776601683794, 0.23713737056616552, 0.1778279410038923, 0.1333521432163324, 0.1, 0.07498942093324558, 0.05623413251903491, 0.042169650342858224, 0.03162277660168379, 0.023713737056616554, 0.01778279410038923, 0.01333521432163324, 0.01, 0.007498942093324558, 0.005623413251903491, 0.004216965034285823, 0.0031622776601683794, 0.0023713737056616554, 0.0017782794100389228, 0.001333521432163324, 0.001, 0.0007498942093324559, 0.0005623413251903491, 0.00042169650342858224, 0.00031622776601683794, 0.00023713737056616554, 0.00017782794100389227, 0.0001333521432163324};

__device__ __forceinline__ unsigned f2bf(float f) { unsigned u = __builtin_bit_cast(unsigned, f); return (u + 0x7fffu + ((u >> 16) & 1u)) >> 16; }
__device__ __forceinline__ unsigned pk2(float lo, float hi) { return f2bf(lo) | (f2bf(hi) << 16); }
__device__ __forceinline__ float wave_sum(float v) {
#pragma unroll
    for (int o = 1; o < 64; o <<= 1) v += __shfl_xor(v, o);
    return v;
}
struct Ctx { int tid, lane, wave, vcu, G, gw, NGW, bx; LAS unsigned char* lds; };

__device__ __forceinline__ int dst_row(int n, int mode) {
    if (mode == 1) { const int up = n >= DFF ? 1 : 0, j = n - up * DFF; return (j >> 7) * 256 + up * 128 + (j & 127); }
    if (mode == 2) { const int h = n / 192, w = n % 192; if (w < 128) return n; const int i = w - 128; return h * 192 + 128 + 2 * (i & 31) + (i >> 5); }
    return n;
}
__device__ __forceinline__ void transpose_mat(const Ctx& C, const float* W, int K, int N, bf16* WT, int mode) {
    LAS float* scr = (LAS float*)(C.lds + C.wave * 16384);
    const int nblk = (N + 31) / 32, nitems = (K / 64) * nblk, lane = C.lane;
    for (int it = C.gw; it < nitems; it += C.NGW) {
        const int kb = it / nblk, nb = it % nblk, k0 = 64 * kb, n0 = 32 * nb;
        const int nn = n0 + (lane & 31);
#pragma unroll 8
        for (int i = 0; i < 32; ++i) { const int kk = 2 * i + (lane >> 5); scr[kk * 33 + (lane & 31)] = nn < N ? W[(size_t)(k0 + kk) * N + nn] : 0.f; }
        asm volatile("s_waitcnt lgkmcnt(0)" ::: "memory");
        const int c = lane & 7;
#pragma unroll
        for (int j = 0; j < 4; ++j) { const int nl = (lane >> 3) + 8 * j, n = n0 + nl; const LAS float* s = scr + (8 * c) * 33 + nl;
            u32x4 o; o.x = pk2(s[0 * 33], s[1 * 33]); o.y = pk2(s[2 * 33], s[3 * 33]); o.z = pk2(s[4 * 33], s[5 * 33]); o.w = pk2(s[6 * 33], s[7 * 33]);
            if (n < N) *(u32x4*)(WT + (size_t)dst_row(n, mode) * K + k0 + 8 * c) = o; }
        asm volatile("s_waitcnt lgkmcnt(0)" ::: "memory");
    }
}
__device__ __forceinline__ void zero_rows(const Ctx& C, bf16* WT, int K, int r0, int r1) {
    const size_t n16 = (size_t)(r1 - r0) * K / 8; u32x4* p = (u32x4*)(WT + (size_t)r0 * K);
    for (size_t i = (size_t)C.gw * 64 + C.lane; i < n16; i += (size_t)C.NGW * 64) p[i] = (u32x4){0u, 0u, 0u, 0u};
}
__device__ __forceinline__ void cvt_rows(const Ctx& C, const float* src, bf16* dst, size_t n) {
    const size_t n8 = n / 8;
    for (size_t i = (size_t)C.gw * 64 + C.lane; i < n8; i += (size_t)C.NGW * 64) { const f32x4 a = *(const f32x4*)(src + 8 * i), b = *(const f32x4*)(src + 8 * i + 4);
        *(u32x4*)(dst + 8 * i) = (u32x4){pk2(a.x, a.y), pk2(a.z, a.w), pk2(b.x, b.y), pk2(b.z, b.w)}; }
}
__device__ __forceinline__ void rope_tables(const Ctx& C, float* rc, float* rs) {
    for (int idx = C.gw * 64 + C.lane; idx < SEQ * 32; idx += C.NGW * 64) {
        const int pos = idx >> 5, i = idx & 31; const double ang = (double)pos * ROPE_INV[i];
        const double k = __builtin_rint(ang * 0.15915494309189535); double r = __builtin_fma(-k, 6.283185307179586, ang); r = __builtin_fma(-k, 2.4492935982947064e-16, r);
        const double r2 = r * r; double sn = 0.0, cs = 0.0;
#pragma unroll
        for (int n = 16; n >= 1; --n) { sn = (1.0 - sn) * (r2 * (1.0 / (double)((2 * n) * (2 * n + 1)))); cs = (1.0 - cs) * (r2 * (1.0 / (double)((2 * n - 1) * (2 * n)))); }
        rs[idx] = (float)(r * (1.0 - sn)); rc[idx] = (float)(1.0 - cs);
    }
}
__device__ __forceinline__ void ln_phase(const Ctx& C, float* Y, const float* g, const float* b, bf16* XB, float* stats, bool final_) {
    const f32x4* g4 = (const f32x4*)g + C.lane; const f32x4* b4 = (const f32x4*)b + C.lane;
    for (int m = C.gw; m < MT; m += C.NGW) {
        f32x4* yr = (f32x4*)(Y + (size_t)m * DM) + C.lane;
        f32x4 v[4]; float s = 0.f;
#pragma unroll
        for (int j = 0; j < 4; ++j) { v[j] = yr[64 * j]; s += (v[j].x + v[j].y) + (v[j].z + v[j].w); }
        const float mean = wave_sum(s) * (1.f / DM); float s2 = 0.f;
#pragma unroll
        for (int j = 0; j < 4; ++j) { const f32x4 d = v[j] - mean; s2 += (d.x * d.x + d.y * d.y) + (d.z * d.z + d.w * d.w); }
        const float rstd = 1.f / sqrtf(wave_sum(s2) * (1.f / DM) + LN_EPS);
        if (final_) {
#pragma unroll
            for (int j = 0; j < 4; ++j) yr[64 * j] = (v[j] - mean) * rstd * g4[64 * j] + b4[64 * j];
        } else {
            if (C.lane == 0) *(f32x2*)(stats + 2 * (size_t)m) = (f32x2){mean, rstd};
            u32x2* o8 = (u32x2*)(XB + (size_t)m * DM) + C.lane;
#pragma unroll
            for (int j = 0; j < 4; ++j) { const f32x4 x = (v[j] - mean) * rstd * g4[64 * j] + b4[64 * j]; o8[64 * j] = (u32x2){pk2(x.x, x.y), pk2(x.z, x.w)}; }
        }
    }
}
__device__ __forceinline__ float logsig(float z) { return fminf(z, 0.f) - log1pf(expf(-fabsf(z))); }
__device__ __forceinline__ void scan_phase(const Ctx& C, const float* __restrict__ flog, const float* __restrict__ bfv, float* __restrict__ nbo) {
    if (C.wave != 0) return;
    for (int bh = C.vcu; bh < NB * 16; bh += C.G) {
        const int bb = bh >> 4, h = bh & 15; const float bias = bfv[h];
        const float* src = flog + ((size_t)bb * SEQ + C.lane) * 16 + h;
        float* dst = nbo + (size_t)bh * SEQ + C.lane;
        double carry = 0.0;
        for (int c0 = 0; c0 < 64; c0 += 16) {
            float v[16];
#pragma unroll
            for (int i = 0; i < 16; ++i) v[i] = src[(size_t)(c0 + i) * 64 * 16];
#pragma unroll
            for (int i = 0; i < 16; ++i) {
                double x = (double)logsig(v[i] + bias);
#pragma unroll
                for (int o = 1; o < 64; o <<= 1) { const double t = __shfl_up(x, o); if (C.lane >= o) x += t; }
                x += carry;
                dst[(c0 + i) * 64] = (float)(-x * 1.4426950408889634);
                carry = __shfl(x, 63);
            }
        }
    }
}
__device__ __forceinline__ void kvpost_phase(const Ctx& C, const float* kvd, const float* kvn, const float* rc, const float* rs, bf16* ckv, bf16* krope) {
    const f32x4 gn = *((const f32x4*)kvn + C.lane);
    for (int m = C.gw; m < MT; m += C.NGW) {
        const float* row = kvd + (size_t)m * 512;
        const f32x4 v = *((const f32x4*)row + C.lane);
        const float ss = wave_sum((v.x * v.x + v.y * v.y) + (v.z * v.z + v.w * v.w));
        const float rr = 1.f / sqrtf(ss * (1.f / 256.f) + RMS_EPS);
        *((u32x2*)(ckv + (size_t)m * 256) + C.lane) = (u32x2){pk2(v.x * rr * gn.x, v.y * rr * gn.y), pk2(v.z * rr * gn.z, v.w * rr * gn.w)};
        if (C.lane < 32) { const int pos = m & (SEQ - 1); const float x1 = row[256 + C.lane], x2 = row[288 + C.lane], c = rc[pos * 32 + C.lane], s = rs[pos * 32 + C.lane];
            *((unsigned*)(krope + (size_t)m * 64) + C.lane) = pk2(x1 * c - x2 * s, x2 * c + x1 * s); }
    }
}
__device__ __forceinline__ void cqpost_phase(const Ctx& C, const float* cq, const float* qn, bf16* cqb) {
    const f32x2 g0 = *((const f32x2*)qn + C.lane), g1 = *((const f32x2*)qn + 64 + C.lane), g2 = *((const f32x2*)qn + 128 + C.lane);
    for (int m = C.gw; m < MT; m += C.NGW) {
        const f32x2* row = (const f32x2*)(cq + (size_t)m * 512) + C.lane;
        const f32x2 a = row[0], b = row[64], c = row[128];
        const float ss = wave_sum((a.x * a.x + a.y * a.y) + (b.x * b.x + b.y * b.y) + (c.x * c.x + c.y * c.y));
        const float rr = 1.f / sqrtf(ss * (1.f / 384.f) + RMS_EPS);
        unsigned* o = (unsigned*)(cqb + (size_t)m * 384) + C.lane;
        o[0] = pk2(a.x * rr * g0.x, a.y * rr * g0.y); o[64] = pk2(b.x * rr * g1.x, b.y * rr * g1.y); o[128] = pk2(c.x * rr * g2.x, c.y * rr * g2.y);
    }
}
#define XB_TMO      128
#define XB_XCNT(j)  (256  + 64 * (j))
#define XB_XSUB(j)  (1280 + 64 * (j))
#define XB_XGEN(j)  (2304 + 64 * (j))
#define XB_TOP      3328
#define XB_TOPGEN   3392
#define XCD_BAR_WORDS 3456
#define XB_SPIN_CAP (1u << 18)

__device__ __forceinline__ unsigned xb_ld(unsigned* p)              { return __hip_atomic_load(p, __ATOMIC_RELAXED, __HIP_MEMORY_SCOPE_AGENT); }
__device__ __forceinline__ unsigned xb_add(unsigned* p, unsigned v) { return __hip_atomic_fetch_add(p, v, __ATOMIC_RELAXED, __HIP_MEMORY_SCOPE_AGENT); }
__device__ __forceinline__ unsigned xb_xcc_id() { return (unsigned)__builtin_amdgcn_s_getreg((3 << 11) | 20) & 0xFu; }
#define XB_SPIN(cond, bar) do { unsigned _sp = 0; while (cond) { __builtin_amdgcn_s_sleep(1); \
    if ((++_sp & 255u) == 0u) { if (xb_ld(&(bar)[XB_TMO])) break; if (_sp > XB_SPIN_CAP) { atomicAdd(&(bar)[XB_TMO], 1u); break; } } } } while (0)

struct XcdBarrier {
    unsigned* bar; unsigned x;
    volatile LAS unsigned* st;
};

__device__ __forceinline__ XcdBarrier xcd_barrier_post(unsigned* bar, volatile LAS unsigned* st) {
    XcdBarrier b; b.bar = bar; b.x = xb_xcc_id(); b.st = st;
    if (threadIdx.x == 0) (void)xb_add(&bar[XB_XCNT(b.x)], 1u);
    return b;
}
__device__ __forceinline__ void xcd_barrier_complete(unsigned* bar, unsigned x, unsigned& nloc, unsigned& nx) {
    const unsigned G = gridDim.x * gridDim.y * gridDim.z;
    unsigned sum, cnt, mine, sp = 0u;
    for (;;) {
        sum = 0u; cnt = 0u; mine = 0u;
#pragma unroll
        for (unsigned j = 0; j < 16; ++j) { const unsigned c = xb_ld(&bar[XB_XCNT(j)]); sum += c; cnt += (c > 0u) ? 1u : 0u; mine = (j == x) ? c : mine; }
        if (sum == G) break;
        __builtin_amdgcn_s_sleep(1);
        if ((++sp & 255u) == 0u) { if (xb_ld(&bar[XB_TMO])) break; if (sp > XB_SPIN_CAP) { atomicAdd(&bar[XB_TMO], 1u); break; } }
    }
    nloc = mine > 0u ? mine : 1u; nx = cnt > 0u ? cnt : 1u;
}

__device__ __forceinline__ void xcd_barrier(const XcdBarrier& b) {
    asm volatile("s_waitcnt vmcnt(0)" ::: "memory");
    __syncthreads();
    if (threadIdx.x == 0) {
        unsigned* bar = b.bar;
        __builtin_amdgcn_s_waitcnt(0);
        unsigned nloc = b.st[0], nx = b.st[1];
        if (nloc == 0u) { xcd_barrier_complete(bar, b.x, nloc, nx); b.st[0] = nloc; b.st[1] = nx; }
        const unsigned old = xb_add(&bar[XB_XSUB(b.x)], 1u);
        const unsigned gen = old / nloc;
        if (old + 1u == (gen + 1u) * nloc) {
            __builtin_amdgcn_fence(__ATOMIC_RELEASE, "agent");
            asm volatile("s_waitcnt vmcnt(0)" ::: "memory");
            const unsigned og = xb_add(&bar[XB_TOP], 1u);
            const unsigned tg = og / nx;
            if (og + 1u == (tg + 1u) * nx) xb_add(&bar[XB_TOPGEN], 1u);
            else XB_SPIN(xb_ld(&bar[XB_TOPGEN]) == tg, bar);
            __builtin_amdgcn_fence(__ATOMIC_ACQUIRE, "agent");
            xb_add(&bar[XB_XGEN(b.x)], 1u);
            asm volatile("s_waitcnt vmcnt(0)" ::: "memory");
        } else {
            XB_SPIN(xb_ld(&bar[XB_XGEN(b.x)]) == gen, bar);
            __builtin_amdgcn_fence(__ATOMIC_ACQUIRE, "agent");
            asm volatile("s_waitcnt vmcnt(0)" ::: "memory");
        }
    }
    __syncthreads();
}

template <int OFF_> __device__ __forceinline__ const float* kargb() {
#if defined(__HIP_DEVICE_COMPILE__)
    const auto kp = __builtin_amdgcn_kernarg_segment_ptr(); const float* r;
    asm volatile("s_load_dwordx2 %0, %1, %2\n\ts_waitcnt lgkmcnt(0)" : "=s"(r) : "s"(kp), "i"(OFF_) : "memory"); return r;
#else
    return nullptr;
#endif
}
template <int OFF_> __device__ __forceinline__ int kargi() {
#if defined(__HIP_DEVICE_COMPILE__)
    const auto kp = __builtin_amdgcn_kernarg_segment_ptr(); int r;
    asm volatile("s_load_dword %0, %1, %2\n\ts_waitcnt lgkmcnt(0)" : "=s"(r) : "s"(kp), "i"(OFF_) : "memory"); return r;
#else
    return 0;
#endif
}
template <class Epi> __device__ __forceinline__ void run_gemm(LAS unsigned char* lds, const bf16* A, const bf16* Bt, int M, int N, int K, int G, int bx, const Epi& E) {
    asm volatile("" : "+s"(K));
    pg8::Gemm g{A, Bt, M, N, K}; pg8::StaticOrder S; S.init(M, N, G, bx);
    pg8::gemm_phase<Epi, pg8::StaticOrder, true, true>(lds, g, S, E);
}

__global__ void __launch_bounds__(512, 2) fwd(Args a) {
    __shared__ __attribute__((aligned(16))) unsigned char lds_raw[LDS_BYTES];
    LAS unsigned char* lds = (LAS unsigned char*)lds_raw;
    const int lo = a.lo, hi = a.hi;
    if (threadIdx.x < 4) ((LAS unsigned*)(lds + LDS_BAR_OFF))[threadIdx.x] = 0u;
    __syncthreads();
    if (hi - lo > 1) (void)xcd_barrier_post((unsigned*)(a.ws + WS_CTL), (volatile LAS unsigned*)(lds + LDS_BAR_OFF));
#define PH_BEGIN Ctx C; { int bx_ = blockIdx.x; asm volatile("" : "+s"(bx_)); C.tid = threadIdx.x; asm volatile("" : "+v"(C.tid)); C.lane = C.tid & 63; C.wave = __builtin_amdgcn_readfirstlane(C.tid >> 6); C.G = kargi<192>(); \
        C.vcu = (C.G % 8 == 0) ? (bx_ % 8) * (C.G / 8) + bx_ / 8 : bx_; C.gw = C.vcu * 8 + C.wave; C.NGW = C.G * 8; C.lds = lds; C.bx = bx_; } \
        unsigned char* ws = (unsigned char*)kargb<176>(); float* Y = (float*)kargb<168>()
#define KARG(k) kargb<(k) * 8>()
#define x_in KARG(0)
#define p_in KARG(1)
#define ln_g KARG(6)
#define ln_b KARG(7)
#define XB ((bf16*)(ws + WS_XB))
#define H ((bf16*)(ws + WS_H))
#define STATS ((float*)(ws + WS_STATS))
#define RC ((float*)(ws + WS_RCOS))
#define RS ((float*)(ws + WS_RSIN))
#define WFIN(l, f) ((bf16*)(ws + WS_FIN + (size_t)((l) * 2 + (f)) * 11 * MiB))
#define WFOUT(l, f) ((bf16*)(ws + WS_FOUT + (size_t)((l) * 2 + (f)) * 22 * QMiB))
#define WPG(l) ((bf16*)(ws + WS_PG + (size_t)(l) * 2 * MiB))
#define WPP(l) ((bf16*)(ws + WS_PP + (size_t)(l) * 2 * QMiB))
#define LNG(l, k) (ln_g + ((l) * 4 + (k)) * DM)
#define LNB(l, k) (ln_b + ((l) * 4 + (k)) * DM)
#ifndef PHASE_MASK
#define PHASE_MASK 0xffffffffull
#endif
#define IN(k) ((((unsigned long long)PHASE_MASK >> (k)) & 1ull) && lo <= (k) && (k) < hi)
#define SEAM(k) do { if ((k) + 1 < hi) { if ((k) == 0) cg::this_grid().sync(); else { XcdBarrier b_; b_.bar = (unsigned*)(ws + WS_CTL); b_.x = xb_xcc_id(); b_.st = (volatile LAS unsigned*)(lds + LDS_BAR_OFF); xcd_barrier(b_); } } } while (0)

    if (IN(0)) { PH_BEGIN;
        for (int l = 0; l < 2; ++l) {
            transpose_mat(C, KARG(2) + (size_t)l * DM * 2 * DFF, DM, 2 * DFF, WFIN(l, 0), 1);
            transpose_mat(C, KARG(4) + (size_t)l * DM * 2 * DFF, DM, 2 * DFF, WFIN(l, 1), 1);
            transpose_mat(C, KARG(3) + (size_t)l * DFF * DM, DFF, DM, WFOUT(l, 0), 0);
            transpose_mat(C, KARG(5) + (size_t)l * DFF * DM, DFF, DM, WFOUT(l, 1), 0);
            transpose_mat(C, KARG(8) + (size_t)l * DM * DM, DM, DM, WPG(l), 0);
            transpose_mat(C, KARG(10) + (size_t)l * PLED * DM, PLED, DM, WPP(l), 0);
        }
        transpose_mat(C, KARG(11), DM, 3088, (bf16*)(ws + WS_FOXIN), 0);
        zero_rows(C, (bf16*)(ws + WS_FOXIN), DM, 3088, 3328);
        transpose_mat(C, KARG(13), DM, DM, (bf16*)(ws + WS_FOXO), 0);
        transpose_mat(C, KARG(14), DM, 384, (bf16*)(ws + WS_DQ), 0);
        zero_rows(C, (bf16*)(ws + WS_DQ), DM, 384, 512);
        transpose_mat(C, KARG(16), 384, 3072, (bf16*)(ws + WS_UQ), 2);
        transpose_mat(C, KARG(17), 2048, DM, (bf16*)(ws + WS_MO), 0);
        transpose_mat(C, KARG(18), DM, 320, (bf16*)(ws + WS_KVD), 0);
        zero_rows(C, (bf16*)(ws + WS_KVD), DM, 320, 512);
        transpose_mat(C, KARG(20), 256, 4096, (bf16*)(ws + WS_KVUP), 0);
        cvt_rows(C, x_in, XB, (size_t)MT * DM);
        rope_tables(C, RC, RS);
        __syncthreads();
        SEAM(0);
    }
#pragma unroll
    for (int l = 0; l < 2; ++l) {
        const int P = 1 + (l == 0 ? 0 : 13);
        if (l == 0) {
            if (IN(1)) { PH_BEGIN; run_gemm(lds, XB, WFIN(0, 0), MT, 2 * DFF, DM, C.G, C.bx, pg8::EpiSwiGLU{H, DFF}); SEAM(1); }
            if (IN(2)) { PH_BEGIN; run_gemm(lds, H, WFOUT(0, 0), MT, DM, DFF, C.G, C.bx, pg8::EpiRes{Y, x_in, STATS, nullptr, nullptr, ALPHA, 0.5f, 0, 0}); SEAM(2); }
            if (IN(3)) { PH_BEGIN; ln_phase(C, Y, LNG(0, 0), LNB(0, 0), XB, STATS, false); SEAM(3); }
#define FQ ((bf16*)(ws + WS_FQ))
#define FK ((bf16*)(ws + WS_FK))
#define FV ((bf16*)(ws + WS_FV))
#define FLOG ((float*)(ws + WS_FLOG))
#define FNB ((float*)(ws + WS_FNB))
            if (IN(4)) { PH_BEGIN; run_gemm(lds, XB, (bf16*)(ws + WS_FOXIN), MT, 3328, DM, C.G, C.bx, pg8::EpiFox{FQ, FK, FV, FLOG, 0.125f * LOG2E}); SEAM(4); }
            if (IN(5)) { PH_BEGIN; scan_phase(C, FLOG, KARG(12), FNB); SEAM(5); }
            if (IN(6)) { PH_BEGIN;
                for (int v = C.vcu; v < 256; v += C.G) { const int bh = v >> 1, s = v & 1, bb = bh >> 4, h = bh & 15; const unsigned base = (unsigned)(((size_t)bb * SEQ * DM + h * 64) * 2);
                    for (int j = 0; j < 8; ++j) { const int gi = j >> 1, qb = (j & 1) ? 4 * gi + 3 - s : 4 * gi + s;
                        att::attn_unit<64, 64, 64, true>(lds, ws, (unsigned)WS_FQ + base, DM, (unsigned)WS_FK + base, DM, 0u, 0, (unsigned)WS_FV + base, DM, (unsigned)WS_FQ + base, DM, FNB + (size_t)bh * SEQ, qb * 256); } }
                SEAM(6);
            }
            if (IN(7)) { PH_BEGIN; run_gemm(lds, FQ, (bf16*)(ws + WS_FOXO), MT, DM, DM, C.G, C.bx, pg8::EpiRes{Y, nullptr, STATS, LNG(0, 0), LNB(0, 0), ALPHA, 1.0f, 1, 0}); SEAM(7); }
            if (IN(8)) { PH_BEGIN; ln_phase(C, Y, LNG(0, 1), LNB(0, 1), XB, STATS, false); SEAM(8); }
        } else {
#define CKV ((bf16*)(ws + WS_CKV))
#define KROPE ((bf16*)(ws + WS_KROPE))
#define CQB ((bf16*)(ws + WS_CQB))
#define KVDF ((float*)(ws + WS_KVDF))
#define CQF ((float*)(ws + WS_CQF))
#define QM ((bf16*)(ws + WS_QM))
#define KN ((bf16*)(ws + WS_KN))
#define VV ((bf16*)(ws + WS_VV))
#define OO ((bf16*)(ws + WS_OO))
            const float qs = 0.07216878364870322f * LOG2E;
            if (IN(14)) { PH_BEGIN; run_gemm(lds, XB, (bf16*)(ws + WS_KVD), MT, 512, DM, C.G, C.bx, pg8::EpiF32{KVDF, 512});
                          run_gemm(lds, XB, WFIN(1, 0), MT, 2 * DFF, DM, C.G, C.bx, pg8::EpiSwiGLU{H, DFF}); SEAM(14); }
            if (IN(15)) { PH_BEGIN; kvpost_phase(C, KVDF, KARG(19), RC, RS, CKV, KROPE);
                          run_gemm(lds, H, WFOUT(1, 0), MT, DM, DFF, C.G, C.bx, pg8::EpiRes{Y, nullptr, STATS, LNG(0, 3), LNB(0, 3), ALPHA, 0.5f, 1, 0}); SEAM(15); }
            if (IN(16)) { PH_BEGIN; ln_phase(C, Y, LNG(1, 0), LNB(1, 0), XB, STATS, false); SEAM(16); }
            if (IN(17)) { PH_BEGIN; run_gemm(lds, XB, (bf16*)(ws + WS_DQ), MT, 512, DM, C.G, C.bx, pg8::EpiF32{CQF, 512}); SEAM(17); }
            if (IN(18)) { PH_BEGIN; cqpost_phase(C, CQF, KARG(15), CQB); SEAM(18); }
#pragma unroll
            for (int hf = 0; hf < 2; ++hf) {
                const int pg = hf == 0 ? 19 : 21, pa = hf == 0 ? 20 : 22;
                if (IN(pg)) { PH_BEGIN;
                    if (hf == 1) run_gemm(lds, OO, (bf16*)(ws + WS_MO), MH, DM, 2048, C.G, C.bx, pg8::EpiRes{Y, nullptr, STATS, LNG(1, 0), LNB(1, 0), ALPHA, 1.0f, 1, 0});
                    run_gemm(lds, CQB + (size_t)hf * MH * 384, (bf16*)(ws + WS_UQ), MH, 3072, 384, C.G, C.bx, pg8::EpiQ{QM, RC, RS, qs});
                    run_gemm(lds, CKV + (size_t)hf * MH * 256, (bf16*)(ws + WS_KVUP), MH, 4096, 256, C.G, C.bx, pg8::EpiKV{KN, VV});
                    SEAM(pg);
                }
                if (IN(pa)) { PH_BEGIN;
                    for (int v = C.vcu; v < 256; v += C.G) { const int bh = v >> 2, s = v & 3, bl = bh >> 4, h = bh & 15; const unsigned lrow = (unsigned)bl * SEQ, grow = (unsigned)(4 * hf + bl) * SEQ;
                        for (int j = 0; j < 4; ++j) { const int gi = j >> 1, qb = (j & 1) ? 8 * gi + 7 - s : 8 * gi + s;
                            att::attn_unit<192, 128, 128, false>(lds, ws, (unsigned)WS_QM + (lrow * 3072 + h * 192) * 2, 3072, (unsigned)WS_KN + (lrow * 2048 + h * 128) * 2, 2048, (unsigned)WS_KROPE + grow * 64 * 2, 64,
                                                                 (unsigned)WS_VV + (lrow * 2048 + h * 128) * 2, 2048, (unsigned)WS_OO + (lrow * 2048 + h * 128) * 2, 2048, nullptr, qb * 256); } }
                    SEAM(pa);
                }
            }
            if (IN(23)) { PH_BEGIN; run_gemm(lds, OO, (bf16*)(ws + WS_MO), MH, DM, 2048, C.G, C.bx, pg8::EpiRes{Y, nullptr, STATS, LNG(1, 0), LNB(1, 0), ALPHA, 1.0f, 1, MH}); SEAM(23); }
            if (IN(24)) { PH_BEGIN; ln_phase(C, Y, LNG(1, 1), LNB(1, 1), XB, STATS, false); SEAM(24); }
        }
        const int Q0 = l == 0 ? 9 : 25;
        if (IN(Q0)) { PH_BEGIN; run_gemm(lds, XB, WFIN(l, 1), MT, 2 * DFF, DM, C.G, C.bx, pg8::EpiSwiGLU{H, DFF}); SEAM(Q0); }
        if (IN(Q0 + 1)) { PH_BEGIN; run_gemm(lds, H, WFOUT(l, 1), MT, DM, DFF, C.G, C.bx, pg8::EpiRes{Y, nullptr, STATS, LNG(l, 1), LNB(l, 1), ALPHA, 0.5f, 1, 0}); SEAM(Q0 + 1); }
        if (IN(Q0 + 2)) { PH_BEGIN; ln_phase(C, Y, LNG(l, 2), LNB(l, 2), XB, STATS, false); cvt_rows(C, p_in + (size_t)l * MT * PLED, (bf16*)(ws + WS_PBF), (size_t)MT * PLED); SEAM(Q0 + 2); }
        if (IN(Q0 + 3)) { PH_BEGIN; bf16* PPA = (bf16*)(ws + WS_PPA);
            run_gemm(lds, (bf16*)(ws + WS_PBF), WPP(l), MT, DM, PLED, C.G, C.bx, pg8::EpiBf16P{PPA, DM});
            run_gemm(lds, XB, WPG(l), MT, DM, DM, C.G, C.bx, pg8::EpiPle{Y, STATS, LNG(l, 2), LNB(l, 2), KARG(9) + l * DM, PPA, ALPHA}); SEAM(Q0 + 3); }
        if (IN(Q0 + 4)) { PH_BEGIN; ln_phase(C, Y, LNG(l, 3), LNB(l, 3), XB, STATS, l == 1); SEAM(Q0 + 4); }
        (void)P;
    }
}

extern "C" void kernel_launch(void* const* d_in, const int* in_sizes, int n_in, void* d_out, int out_size, void* d_ws, size_t ws_size, hipStream_t stream) {
    static int grid = 0;
    if (grid == 0) {
        if (n_in != 21 || out_size != MT * DM || ws_size < WS_END) { fprintf(stderr, "kernel_launch: unexpected shapes: n_in %d out %d ws %zu (need %zu)\n", n_in, out_size, ws_size, (size_t)WS_END); grid = -1; return; }
        int dev = 0, cus = 0;
        if (hipGetDevice(&dev) != hipSuccess || hipDeviceGetAttribute(&cus, hipDeviceAttributeMultiprocessorCount, dev) != hipSuccess) { grid = -1; return; }
        int per_cu = 0;
        if (hipOccupancyMaxActiveBlocksPerMultiprocessor(&per_cu, (const void*)fwd, 512, 0) != hipSuccess || per_cu < 1) fprintf(stderr, "kernel_launch: occupancy query says %d\n", per_cu);
        (void)hipGetLastError();
        grid = cus;
    }
    if (grid < 0) return;
    if (hipMemsetAsync((char*)d_ws + WS_CTL, 0, CTL_BYTES, stream) != hipSuccess) { fprintf(stderr, "kernel_launch: memset failed\n"); return; }
    Args a{};
    for (int i = 0; i < 21; ++i) a.in[i] = (const float*)d_in[i];
    a.out = (float*)d_out; a.ws = (unsigned char*)d_ws; a.G = grid;
#if MULTI_LAUNCH
    for (int ph = 0; ph < NPHASE; ++ph) { a.lo = ph; a.hi = ph + 1; hipLaunchKernelGGL(fwd, dim3(grid), dim3(512), 0, stream, a); }
#else
    a.lo = 0; a.hi = NPHASE;
    void* args[] = {&a};
    hipError_t e = hipLaunchCooperativeKernel((const void*)fwd, dim3(grid), dim3(512), args, 0, stream);
    if (e != hipSuccess) fprintf(stderr, "cooperative launch failed: %s (grid %d)\n", hipGetErrorString(e), grid);
#endif
}
```

```cpp
#include <hip/hip_runtime.h>
#include <hip/hip_cooperative_groups.h>
#include <cstdio>
#include <cstdint>
#include <cmath>
namespace cg = cooperative_groups;
#ifndef MULTI_LAUNCH
#define MULTI_LAUNCH 0
#endif
namespace pg8 {
#define PG8_LAS __attribute__((address_space(3)))
typedef unsigned short bf16_t;
typedef short bf16x8 __attribute__((ext_vector_type(8)));
typedef float f32x4 __attribute__((ext_vector_type(4)));
typedef unsigned u32x4 __attribute__((ext_vector_type(4)));
constexpr int BM = 256, BK = 64, HALF = 128, HTB = HALF * BK * 2  , STAGE_BYTES = 8 * HTB, NXCD = 8, WGM = 8;

__host__ __device__ __forceinline__ int lds_byte(int r, int c) { const int st = (r >> 4) * 2 + (c >> 5), rr = r & 15, cc = c & 31, ob = rr * 64 + cc * 2; return st * 1024 + (ob ^ (((ob >> 9) & 1) << 5)); }
__host__ __device__ __forceinline__ void stage_rc(int b, int& R, int& C) { const int st = b / 1024, sb = b % 1024, swz = sb ^ (((sb >> 9) & 1) << 5); R = (st >> 1) * 16 + swz / 64; C = (st & 1) * 32 + (swz % 64) / 2; }
__host__ __device__ __forceinline__ int perm32(int rho) { const int n = rho >> 4, i = rho & 15; return 8 * (i >> 2) + 4 * n + (i & 3); }

struct Unit { int pm, pn; };
struct Gemm { const bf16_t* A; const bf16_t* Bt; int M, N, K; };

struct StaticOrder {
    int nM, nN, nwg, G, c;
    __host__ __device__ void init(int M, int N, int G_, int c_) { nM = M / BM; nN = N / BM; nwg = nM * nN; G = G_; c = c_; }
    __host__ __device__ bool next(int i, Unit& u) const {
        const long L = (long)i * G + c; if (L >= nwg) return false;
        int wgid = (int)L; { const int q = nwg / NXCD, r = nwg % NXCD, xcd = wgid % NXCD, off = wgid / NXCD; wgid = (xcd < r ? xcd * (q + 1) : r * (q + 1) + (xcd - r) * q) + off; }
        const int nig = WGM * nN, gid = wgid / nig, fm = gid * WGM, gsz = (nM - fm) < WGM ? (nM - fm) : WGM;
        u.pm = fm + ((wgid % nig) % gsz); u.pn = (wgid % nig) / gsz; return true;
    }
    __device__ __forceinline__ void a_ready(const Unit&) const {}
    __device__ __forceinline__ void done(const Unit&) const {}
};
__device__ __forceinline__ unsigned cvt_pk_bf16(float lo, float hi) { unsigned r; asm volatile("v_cvt_pk_bf16_f32 %0, %1, %2" : "=v"(r) : "v"(lo), "v"(hi)); return r; }
typedef float f32x2 __attribute__((ext_vector_type(2)));
typedef unsigned u32x2 __attribute__((ext_vector_type(2)));
__device__ __forceinline__ float silu_f(float g) { return g * __builtin_amdgcn_rcpf(1.0f + __builtin_amdgcn_exp2f(-1.4426950408889634f * g)); }
__device__ __forceinline__ float sigm_f(float g) { return __builtin_amdgcn_rcpf(1.0f + __builtin_amdgcn_exp2f(-1.4426950408889634f * g)); }

struct EpiBf16P {
    static constexpr bool PERM = true, AFTER_DRAIN = false;
    bf16_t* O; int ldc;
    __device__ __forceinline__ void operator()(const f32x4 (&acc)[2][2][4][2], const Unit& u, int wr, int wc, int fr, int fq) const {
        asm volatile("" : "+v"(fr), "+v"(fq));
        const int row0 = u.pm * BM + wr * 64 + fr, col0 = u.pn * BM + wc * 32 + 8 * fq;
#pragma unroll
        for (int ai = 0; ai < 2; ++ai)
#pragma unroll
            for (int m = 0; m < 4; ++m) { bf16_t* rowp = O + (size_t)(row0 + ai * HALF + m * 16) * ldc + col0;
#pragma unroll
                for (int bj = 0; bj < 2; ++bj) { const f32x4 v0 = acc[ai][bj][m][0], v1 = acc[ai][bj][m][1];
                    u32x4 w; w.x = cvt_pk_bf16(v0[0], v0[1]); w.y = cvt_pk_bf16(v0[2], v0[3]); w.z = cvt_pk_bf16(v1[0], v1[1]); w.w = cvt_pk_bf16(v1[2], v1[3]);
                    *(u32x4*)(rowp + bj * HALF) = w; } }
    }
};
struct EpiSwiGLU {
    static constexpr bool PERM = true, AFTER_DRAIN = false;
    bf16_t* H; int ldh;
    __device__ __forceinline__ void operator()(const f32x4 (&acc)[2][2][4][2], const Unit& u, int wr, int wc, int fr, int fq) const {
        asm volatile("" : "+v"(fr), "+v"(fq));
        const int row0 = u.pm * BM + wr * 64 + fr, col0 = u.pn * HALF + wc * 32 + 8 * fq;
#pragma unroll
        for (int ai = 0; ai < 2; ++ai)
#pragma unroll
            for (int m = 0; m < 4; ++m) { bf16_t* rowp = H + (size_t)(row0 + ai * HALF + m * 16) * ldh + col0;
                const f32x4 g0 = acc[ai][0][m][0], g1 = acc[ai][0][m][1], u0 = acc[ai][1][m][0], u1 = acc[ai][1][m][1];
                u32x4 w;
                w.x = cvt_pk_bf16(silu_f(g0[0]) * u0[0], silu_f(g0[1]) * u0[1]); w.y = cvt_pk_bf16(silu_f(g0[2]) * u0[2], silu_f(g0[3]) * u0[3]);
                w.z = cvt_pk_bf16(silu_f(g1[0]) * u1[0], silu_f(g1[1]) * u1[1]); w.w = cvt_pk_bf16(silu_f(g1[2]) * u1[2], silu_f(g1[3]) * u1[3]);
                *(u32x4*)rowp = w; }
    }
};
struct EpiF32 {
    static constexpr bool PERM = false, AFTER_DRAIN = false;
    float* C; int ldc;
    __device__ __forceinline__ void operator()(const f32x4 (&acc)[2][2][4][2], const Unit& u, int wr, int wc, int fr, int fq) const {
        asm volatile("" : "+v"(fr), "+v"(fq));
        const int row0 = u.pm * BM + wr * 64 + fr, col0 = u.pn * BM + wc * 32 + 4 * fq;
#pragma unroll
        for (int ai = 0; ai < 2; ++ai)
#pragma unroll
            for (int m = 0; m < 4; ++m) { float* rowp = C + (size_t)(row0 + ai * HALF + m * 16) * ldc + col0;
#pragma unroll
                for (int bj = 0; bj < 2; ++bj)
#pragma unroll
                    for (int n = 0; n < 2; ++n) *(f32x4*)(rowp + bj * HALF + n * 16) = acc[ai][bj][m][n]; }
    }
};
struct EpiRes {
    static constexpr bool PERM = false, AFTER_DRAIN = false;
    float* Y; const float* Xin; const float* stats; const float* g; const float* b; float alpha, scale; int mode, row_off;
    __device__ __forceinline__ void operator()(const f32x4 (&acc)[2][2][4][2], const Unit& u, int wr, int wc, int fr, int fq) const {
        asm volatile("" : "+v"(fr), "+v"(fq));
        const int row0 = row_off + u.pm * BM + wr * 64 + fr, col0 = u.pn * BM + wc * 32 + 4 * fq;
#pragma unroll
        for (int bj = 0; bj < 2; ++bj)
#pragma unroll
            for (int n = 0; n < 2; ++n) { const int c = col0 + bj * HALF + n * 16;
                f32x4 gv = (f32x4){1.f, 1.f, 1.f, 1.f}, bv = (f32x4){0.f, 0.f, 0.f, 0.f};
                if (mode) { gv = *(const f32x4*)(g + c); bv = *(const f32x4*)(b + c); }
#pragma unroll
                for (int ai = 0; ai < 2; ++ai)
#pragma unroll
                    for (int m = 0; m < 4; ++m) { const int r = row0 + ai * HALF + m * 16; const size_t off = (size_t)r * 1024 + c;
                        f32x4 xo;
                        if (mode) { const f32x2 st = *(const f32x2*)(stats + 2 * (size_t)r); const f32x4 yo = *(const f32x4*)(Y + off); xo = (yo - st.x) * st.y * gv + bv; }
                        else xo = *(const f32x4*)(Xin + off);
                        *(f32x4*)(Y + off) = xo * alpha + acc[ai][bj][m][n] * scale; } }
    }
};
struct EpiPle {
    static constexpr bool PERM = true, AFTER_DRAIN = false;
    float* Y; const float* stats; const float* g; const float* b; const float* bg; const bf16_t* PP; float alpha;
    __device__ __forceinline__ void operator()(const f32x4 (&acc)[2][2][4][2], const Unit& u, int wr, int wc, int fr, int fq) const {
        asm volatile("" : "+v"(fr), "+v"(fq));
        const int row0 = u.pm * BM + wr * 64 + fr, col0 = u.pn * BM + wc * 32 + 8 * fq;
#pragma unroll
        for (int bj = 0; bj < 2; ++bj) { const int c = col0 + bj * HALF;
            const f32x4 g0 = *(const f32x4*)(g + c), g1 = *(const f32x4*)(g + c + 4), b0 = *(const f32x4*)(b + c), b1 = *(const f32x4*)(b + c + 4);
            const f32x4 q0 = *(const f32x4*)(bg + c), q1 = *(const f32x4*)(bg + c + 4);
#pragma unroll
            for (int ai = 0; ai < 2; ++ai)
#pragma unroll
                for (int m = 0; m < 4; ++m) { const int r = row0 + ai * HALF + m * 16; const size_t off = (size_t)r * 1024 + c;
                    const f32x2 st = *(const f32x2*)(stats + 2 * (size_t)r);
                    const f32x4 y0 = *(const f32x4*)(Y + off), y1 = *(const f32x4*)(Y + off + 4);
                    const u32x4 pw = *(const u32x4*)(PP + off);
                    const f32x4 x0 = (y0 - st.x) * st.y * g0 + b0, x1 = (y1 - st.x) * st.y * g1 + b1;
                    const f32x4 a0 = acc[ai][bj][m][0] + q0, a1 = acc[ai][bj][m][1] + q1;
                    f32x4 p0, p1;
                    p0[0] = __uint_as_float(pw.x << 16); p0[1] = __uint_as_float(pw.x & 0xffff0000u); p0[2] = __uint_as_float(pw.y << 16); p0[3] = __uint_as_float(pw.y & 0xffff0000u);
                    p1[0] = __uint_as_float(pw.z << 16); p1[1] = __uint_as_float(pw.z & 0xffff0000u); p1[2] = __uint_as_float(pw.w << 16); p1[3] = __uint_as_float(pw.w & 0xffff0000u);
                    f32x4 o0, o1;
#pragma unroll
                    for (int e = 0; e < 4; ++e) { o0[e] = x0[e] * alpha + sigm_f(a0[e]) * p0[e]; o1[e] = x1[e] * alpha + sigm_f(a1[e]) * p1[e]; }
                    *(f32x4*)(Y + off) = o0; *(f32x4*)(Y + off + 4) = o1; asm volatile("" ::: "memory"); } }
    }
};
struct EpiFox {
    static constexpr bool PERM = true, AFTER_DRAIN = false;
    bf16_t* Q; bf16_t* K; bf16_t* V; float* flog; float qscale;
    __device__ __forceinline__ void operator()(const f32x4 (&acc)[2][2][4][2], const Unit& u, int wr, int wc, int fr, int fq) const {
        asm volatile("" : "+v"(fr), "+v"(fq));
        const int row0 = u.pm * BM + wr * 64 + fr;
        if (u.pn == 12) {
            if (wc == 0 && fq < 2) {
#pragma unroll
                for (int ai = 0; ai < 2; ++ai)
#pragma unroll
                    for (int m = 0; m < 4; ++m) { float* p = flog + (size_t)(row0 + ai * HALF + m * 16) * 16 + 8 * fq;
                        *(f32x4*)p = acc[ai][0][m][0]; *(f32x4*)(p + 4) = acc[ai][0][m][1]; }
            }
            return;
        }
        const int t = u.pn >> 2; bf16_t* base = Q + (size_t)t * ((size_t)64 << 19); const float sc = t == 0 ? qscale : 1.0f;
        const int col0 = (u.pn & 3) * BM + wc * 32 + 8 * fq;
#pragma unroll
        for (int ai = 0; ai < 2; ++ai)
#pragma unroll
            for (int m = 0; m < 4; ++m) { bf16_t* rowp = base + (size_t)(row0 + ai * HALF + m * 16) * 1024 + col0;
#pragma unroll
                for (int bj = 0; bj < 2; ++bj) { const f32x4 v0 = acc[ai][bj][m][0] * sc, v1 = acc[ai][bj][m][1] * sc;
                    u32x4 w; w.x = cvt_pk_bf16(v0[0], v0[1]); w.y = cvt_pk_bf16(v0[2], v0[3]); w.z = cvt_pk_bf16(v1[0], v1[1]); w.w = cvt_pk_bf16(v1[2], v1[3]);
                    *(u32x4*)(rowp + bj * HALF) = w; } }
    }
};
struct EpiQ {
    static constexpr bool PERM = true, AFTER_DRAIN = false;
    bf16_t* QM; const float* rcos; const float* rsin; float qscale;
    __device__ __forceinline__ void operator()(const f32x4 (&acc)[2][2][4][2], const Unit& u, int wr, int wc, int fr, int fq) const {
        asm volatile("" : "+v"(fr), "+v"(fq));
        const int row0 = u.pm * BM + wr * 64 + fr, col0 = u.pn * BM + wc * 32 + 8 * fq;
#pragma unroll
        for (int bj = 0; bj < 2; ++bj) { const int c = col0 + bj * HALF; const int w0 = c % 192; const bool rp = w0 >= 128; const int i0 = rp ? (w0 - 128) >> 1 : 0;
#pragma unroll
            for (int ai = 0; ai < 2; ++ai)
#pragma unroll
                for (int m = 0; m < 4; ++m) { const int r = row0 + ai * HALF + m * 16;
                    f32x4 v0 = acc[ai][bj][m][0], v1 = acc[ai][bj][m][1];
                    if (rp) { const int pos = r & 4095; const f32x4 cs = *(const f32x4*)(rcos + pos * 32 + i0), sn = *(const f32x4*)(rsin + pos * 32 + i0);
                        f32x4 t0, t1;
                        t0[0] = v0[0] * cs[0] - v0[1] * sn[0]; t0[1] = v0[1] * cs[0] + v0[0] * sn[0]; t0[2] = v0[2] * cs[1] - v0[3] * sn[1]; t0[3] = v0[3] * cs[1] + v0[2] * sn[1];
                        t1[0] = v1[0] * cs[2] - v1[1] * sn[2]; t1[1] = v1[1] * cs[2] + v1[0] * sn[2]; t1[2] = v1[2] * cs[3] - v1[3] * sn[3]; t1[3] = v1[3] * cs[3] + v1[2] * sn[3];
                        v0 = t0; v1 = t1; }
                    v0 = v0 * qscale; v1 = v1 * qscale;
                    u32x4 w; w.x = cvt_pk_bf16(v0[0], v0[1]); w.y = cvt_pk_bf16(v0[2], v0[3]); w.z = cvt_pk_bf16(v1[0], v1[1]); w.w = cvt_pk_bf16(v1[2], v1[3]);
                    *(u32x4*)(QM + (size_t)r * 3072 + c) = w; asm volatile("" ::: "memory"); } }
    }
};
struct EpiKV {
    static constexpr bool PERM = true, AFTER_DRAIN = false;
    bf16_t* KN; bf16_t* VV;
    __device__ __forceinline__ void operator()(const f32x4 (&acc)[2][2][4][2], const Unit& u, int wr, int wc, int fr, int fq) const {
        asm volatile("" : "+v"(fr), "+v"(fq));
        const int row0 = u.pm * BM + wr * 64 + fr, col0 = u.pn * HALF + wc * 32 + 8 * fq;
#pragma unroll
        for (int ai = 0; ai < 2; ++ai)
#pragma unroll
            for (int m = 0; m < 4; ++m) { const size_t off = (size_t)(row0 + ai * HALF + m * 16) * 2048 + col0;
#pragma unroll
                for (int bj = 0; bj < 2; ++bj) { const f32x4 v0 = acc[ai][bj][m][0], v1 = acc[ai][bj][m][1];
                    u32x4 w; w.x = cvt_pk_bf16(v0[0], v0[1]); w.y = cvt_pk_bf16(v0[2], v0[3]); w.z = cvt_pk_bf16(v1[0], v1[1]); w.w = cvt_pk_bf16(v1[2], v1[3]);
                    *(u32x4*)((bj == 0 ? KN : VV) + off) = w; } }
    }
};
template <class Epi, class Sched, bool ALIGN_EPI = false, bool SP2 = false>
__device__ __forceinline__ void gemm_phase(PG8_LAS unsigned char* lds, const Gemm g, const Sched& S, const Epi& E) {
    int tid_ = threadIdx.x; asm volatile("" : "+v"(tid_));
    const int tid = tid_, wid = __builtin_amdgcn_readfirstlane(tid >> 6), lane = tid & 63, wr = wid >> 2, wc = wid & 3, fr = lane & 15, fq = lane >> 4;
    const int K = g.K, nt = K / BK;
    unsigned voffA[2], voffB[2];
#pragma unroll
    for (int i = 0; i < 2; ++i) { int R, C; stage_rc(tid * 16 + i * 8192, R, C); const int Rb = Epi::PERM ? ((R & ~31) + perm32(R & 31)) : R;
        voffA[i] = (unsigned)(R * K + C) * 2u; voffB[i] = (unsigned)(Rb * K + C) * 2u; }
    const size_t kstep = (size_t)(BK * 2);
    const size_t hstep = (size_t)HALF * K * 2;
    const size_t tstep = 2 * hstep;
    const unsigned ldsw = (unsigned)wid * 1024u;
    const int aoff = lds_byte(wr * 64 + fr, fq * 8), boff = lds_byte(wc * 32 + fr, fq * 8);
#define PG8_SA(b, h) (((b) * 2 + (h)) * HTB)
#define PG8_SB(b, h) ((4 + (b) * 2 + (h)) * HTB)
#define PG8_STAGE(bufoff, gbase, voff) do { _Pragma("unroll") for (int _i = 0; _i < 2; ++_i) \
        __builtin_amdgcn_global_load_lds((const unsigned*)((const char*)(gbase) + (voff)[_i]), (PG8_LAS unsigned*)(lds + (bufoff) + ldsw + _i * 8192), 16, 0, 0); } while (0)
#define PG8_LDA(dst, b, h) do { _Pragma("unroll") for (int m = 0; m < 4; ++m) _Pragma("unroll") for (int k = 0; k < 2; ++k) dst[m][k] = *(const PG8_LAS bf16x8*)(lds + PG8_SA(b, h) + aoff + m * 2048 + k * 1024); } while (0)
#define PG8_LDB(dst, b, h) do { _Pragma("unroll") for (int n = 0; n < 2; ++n) _Pragma("unroll") for (int k = 0; k < 2; ++k) dst[n][k] = *(const PG8_LAS bf16x8*)(lds + PG8_SB(b, h) + boff + n * 2048 + k * 1024); } while (0)
#define PG8_MMA(ai, bj, At, Bt) do { __builtin_amdgcn_s_setprio(1); _Pragma("unroll") for (int m = 0; m < 4; ++m) _Pragma("unroll") for (int n = 0; n < 2; ++n) _Pragma("unroll") for (int k = 0; k < 2; ++k) \
        acc[ai][bj][m][n] = __builtin_amdgcn_mfma_f32_16x16x32_bf16(Bt[n][k], At[m][k], acc[ai][bj][m][n], 0, 0, 0); __builtin_amdgcn_s_setprio(0); } while (0)
#define PG8_WAIT_V(n) asm volatile("s_waitcnt vmcnt(" #n ")" ::: "memory")
#define PG8_WAIT_L(n) asm volatile("s_waitcnt lgkmcnt(" #n ")" ::: "memory")
#define PG8_BAR __builtin_amdgcn_s_barrier()
#define PG8_SCHED __builtin_amdgcn_sched_barrier(0)
    Unit cur, nxt; int ui = 0;
    if (!S.next(0, cur)) return;
    f32x4 acc[2][2][4][2];
#pragma unroll
    for (int a = 0; a < 2; ++a)
#pragma unroll
        for (int b = 0; b < 2; ++b)
#pragma unroll
            for (int m = 0; m < 4; ++m)
#pragma unroll
                for (int n = 0; n < 2; ++n) acc[a][b][m][n] = (f32x4){0.f, 0.f, 0.f, 0.f};
    bf16x8 At[4][2], B0[2][2], B1[2][2];
    const char* cA = (const char*)g.A + (size_t)cur.pm * tstep; const char* cB = (const char*)g.Bt + (size_t)cur.pn * tstep;
    S.a_ready(cur);
    if constexpr (SP2) {
        PG8_STAGE(PG8_SB(0, 0), cB, voffB); PG8_STAGE(PG8_SB(0, 1), cB + hstep, voffB); PG8_STAGE(PG8_SA(0, 0), cA, voffA); PG8_STAGE(PG8_SA(0, 1), cA + hstep, voffA);
        if (wr == 1) PG8_BAR;
        PG8_WAIT_V(2); PG8_BAR;
        PG8_STAGE(PG8_SB(1, 0), cB + kstep, voffB); PG8_STAGE(PG8_SA(1, 0), cA + kstep, voffA); PG8_STAGE(PG8_SB(1, 1), cB + hstep + kstep, voffB);
        PG8_WAIT_V(6); PG8_BAR;
    } else {
        PG8_STAGE(PG8_SB(0, 0), cB, voffB); PG8_STAGE(PG8_SA(0, 0), cA, voffA); PG8_STAGE(PG8_SB(0, 1), cB + hstep, voffB); PG8_STAGE(PG8_SA(0, 1), cA + hstep, voffA);
        if (wr == 1) PG8_BAR;
        PG8_WAIT_V(4); PG8_BAR;
        PG8_STAGE(PG8_SB(1, 0), cB + kstep, voffB); PG8_STAGE(PG8_SA(1, 0), cA + kstep, voffA); PG8_STAGE(PG8_SB(1, 1), cB + hstep + kstep, voffB);
        PG8_WAIT_V(6); PG8_BAR;
    }
    for (;;) {
        const bool has_next = S.next(ui + 1, nxt);
        const char* nA = has_next ? (const char*)g.A + (size_t)nxt.pm * tstep : cA; const char* nB = has_next ? (const char*)g.Bt + (size_t)nxt.pn * tstep : cB;
        for (int t = 0; t < nt; t += 2) {
            const bool last = (t == nt - 2);
            const char* a1 = cA + (size_t)(t + 1) * kstep;
            const char* a2 = last ? nA : cA + (size_t)(t + 2) * kstep; const char* b2 = last ? nB : cB + (size_t)(t + 2) * kstep;
            const char* a3 = a2 + kstep; const char* b3 = b2 + kstep;
            if (last && has_next) S.a_ready(nxt);
            if constexpr (SP2) {
            PG8_LDB(B0, 0, 0); PG8_LDB(B1, 0, 1); PG8_SCHED; PG8_LDA(At, 0, 0); PG8_STAGE(PG8_SA(1, 1), a1 + hstep, voffA);
            PG8_WAIT_V(8); PG8_WAIT_L(0); PG8_BAR; PG8_MMA(0, 0, At, B0); PG8_MMA(0, 1, At, B1); PG8_BAR; PG8_SCHED;
            PG8_LDA(At, 0, 1); PG8_STAGE(PG8_SB(0, 0), b2, voffB); PG8_STAGE(PG8_SB(0, 1), b2 + hstep, voffB); PG8_STAGE(PG8_SA(0, 0), a2, voffA);
            PG8_WAIT_V(8); PG8_WAIT_L(0); PG8_BAR; PG8_MMA(1, 0, At, B0); PG8_MMA(1, 1, At, B1); PG8_BAR; PG8_SCHED;
            PG8_LDB(B0, 1, 0); PG8_LDB(B1, 1, 1); PG8_SCHED; PG8_LDA(At, 1, 0); PG8_STAGE(PG8_SA(0, 1), a2 + hstep, voffA);
            PG8_WAIT_V(8); PG8_WAIT_L(0); PG8_BAR; PG8_MMA(0, 0, At, B0); PG8_MMA(0, 1, At, B1); PG8_BAR; PG8_SCHED;
            PG8_LDA(At, 1, 1); PG8_STAGE(PG8_SB(1, 0), b3, voffB); PG8_STAGE(PG8_SB(1, 1), b3 + hstep, voffB); PG8_STAGE(PG8_SA(1, 0), a3, voffA);
            PG8_WAIT_V(8); PG8_WAIT_L(0); PG8_BAR; PG8_MMA(1, 0, At, B0); PG8_MMA(1, 1, At, B1); PG8_BAR; PG8_SCHED;
            } else {
            PG8_LDB(B0, 0, 0); PG8_SCHED; PG8_LDA(At, 0, 0); PG8_STAGE(PG8_SA(1, 1), a1 + hstep, voffA);
            PG8_WAIT_L(8); PG8_BAR; PG8_WAIT_L(0); PG8_MMA(0, 0, At, B0); PG8_BAR; PG8_SCHED;
            PG8_LDB(B1, 0, 1); PG8_STAGE(PG8_SB(0, 0), b2, voffB);
            PG8_BAR; PG8_WAIT_L(0); PG8_MMA(0, 1, At, B1); PG8_BAR;
            PG8_LDA(At, 0, 1); PG8_STAGE(PG8_SA(0, 0), a2, voffA);
            PG8_BAR; PG8_WAIT_L(0); PG8_MMA(1, 0, At, B0); PG8_BAR; PG8_SCHED;
            PG8_STAGE(PG8_SB(0, 1), b2 + hstep, voffB);
            PG8_WAIT_V(6); PG8_BAR; PG8_MMA(1, 1, At, B1); PG8_BAR;
            PG8_LDB(B0, 1, 0); PG8_SCHED; PG8_LDA(At, 1, 0); PG8_STAGE(PG8_SA(0, 1), a2 + hstep, voffA);
            PG8_WAIT_L(8); PG8_BAR; PG8_WAIT_L(0); PG8_MMA(0, 0, At, B0); PG8_BAR; PG8_SCHED;
            PG8_LDB(B1, 1, 1); PG8_STAGE(PG8_SB(1, 0), b3, voffB);
            PG8_BAR; PG8_WAIT_L(0); PG8_MMA(0, 1, At, B1); PG8_BAR;
            PG8_LDA(At, 1, 1); PG8_STAGE(PG8_SA(1, 0), a3, voffA);
            PG8_BAR; PG8_WAIT_L(0); PG8_MMA(1, 0, At, B0); PG8_BAR; PG8_SCHED;
            PG8_STAGE(PG8_SB(1, 1), b3 + hstep, voffB);
            PG8_WAIT_V(6); PG8_BAR; PG8_MMA(1, 1, At, B1); PG8_BAR;
            }
        }
        if constexpr (ALIGN_EPI) { if (wr == 0) PG8_BAR; }
        if constexpr (!Epi::AFTER_DRAIN) { E(acc, cur, wr, wc, fr, fq); S.done(cur); }
        if (!has_next) break;
#pragma unroll
        for (int a = 0; a < 2; ++a)
#pragma unroll
            for (int b = 0; b < 2; ++b)
#pragma unroll
                for (int m = 0; m < 4; ++m)
#pragma unroll
                    for (int n = 0; n < 2; ++n) acc[a][b][m][n] = (f32x4){0.f, 0.f, 0.f, 0.f};
        cur = nxt; cA = nA; cB = nB; ++ui;
        if constexpr (ALIGN_EPI) { if (wr == 1) PG8_BAR; }
    }
    PG8_WAIT_V(0);
    if constexpr (!ALIGN_EPI) { if (wr == 0) PG8_BAR; }
    PG8_BAR;
    if constexpr (Epi::AFTER_DRAIN) { E.fused(acc, cur, wr, wc, fr, fq, lds, wid, lane); S.done(cur); }
#undef PG8_SA
#undef PG8_SB
#undef PG8_STAGE
#undef PG8_LDA
#undef PG8_LDB
#undef PG8_MMA
#undef PG8_WAIT_V
#undef PG8_WAIT_L
#undef PG8_BAR
#undef PG8_SCHED
}
}
namespace att {
#define ALAS __attribute__((address_space(3)))
typedef unsigned short bf16_t;
typedef short bf16x8 __attribute__((ext_vector_type(8)));
typedef short s16x4 __attribute__((ext_vector_type(4)));
typedef float f32x16 __attribute__((ext_vector_type(16)));
typedef float f32x4 __attribute__((ext_vector_type(4)));
typedef unsigned u32x4 __attribute__((ext_vector_type(4)));
typedef unsigned u32x2 __attribute__((ext_vector_type(2)));
typedef float f32x2_t __attribute__((ext_vector_type(2))); typedef __bf16 bf16x2_t __attribute__((ext_vector_type(2)));
__device__ __forceinline__ unsigned cvtpk(float lo, float hi) { f32x2_t v = {lo, hi}; bf16x2_t b = __builtin_convertvector(v, bf16x2_t); return __builtin_bit_cast(unsigned, b); }
__device__ __forceinline__ s16x4 vtr(const ALAS unsigned char* p) { return __builtin_bit_cast(s16x4, __builtin_amdgcn_ds_read_tr16_b64_v4i16((ALAS s16x4*)p)); }

template <int DQK, int DN, int DV, bool BIAS, bool PIPE>
__device__ __forceinline__ void attn_unit(ALAS unsigned char* lds, const unsigned char* wsb, unsigned qoff, int qp, unsigned knoff, int knp, unsigned kroff, int krp,
                                          unsigned voff, int vp, unsigned ooff, int op, const float* nb, int q0) {
    constexpr int KP = DQK * 2 + 16, KBUF = 64 * KP, VBUF = 64 * DV * 2, OFF_V = 2 * KBUF, OFF_B = OFF_V + 3 * VBUF;
    constexpr int NKN = DN / 64, NKR = (DQK - DN) / 64, NVC = DV / 64, NST = DQK / 16, NDB = DV / 32;
    int tid_ = threadIdx.x; asm volatile("" : "+v"(tid_));
    const int tid = tid_, lane = tid & 63, r32 = lane & 31, hi = lane >> 5; const int wid = __builtin_amdgcn_readfirstlane(tid >> 6);
    const int NT = (q0 + 256) / 64;
    const int qrow = q0 + 32 * wid + r32, qmin = q0 + 32 * wid, qmax = qmin + 31;
    const int skey = tid >> 3, sc = tid & 7;
    const unsigned lkn = (unsigned)(skey * knp * 2 + sc * 16), lkr = (unsigned)(skey * krp * 2 + sc * 16), lv = (unsigned)(skey * vp * 2 + sc * 16);
    const unsigned tkn = 64u * (unsigned)knp * 2u, tkr = 64u * (unsigned)krp * 2u, tv = 64u * (unsigned)vp * 2u;
    u32x4 kreg[NKN + NKR], vreg[NVC]; f32x4 breg = (f32x4){0.f, 0.f, 0.f, 0.f};
#define ATT_LOADK(t) do { \
    _Pragma("unroll") for (int i_ = 0; i_ < NKN; ++i_) kreg[i_] = *(const u32x4*)(wsb + (size_t)(knoff + (unsigned)(t) * tkn + lkn) + i_ * 128); \
    _Pragma("unroll") for (int i_ = 0; i_ < NKR; ++i_) kreg[NKN + i_] = *(const u32x4*)(wsb + (size_t)(kroff + (unsigned)(t) * tkr + lkr) + i_ * 128); \
    if (BIAS) { if (tid < 16) breg = *(const f32x4*)(nb + 64 * (t) + 4 * tid); } } while (0)
#define ATT_LOADV(t) do { \
    _Pragma("unroll") for (int i_ = 0; i_ < NVC; ++i_) vreg[i_] = *(const u32x4*)(wsb + (size_t)(voff + (unsigned)(t) * tv + lv) + i_ * 128); } while (0)
#define ATT_STOREK(buf) do { \
    _Pragma("unroll") for (int i_ = 0; i_ < NKN + NKR; ++i_) *(ALAS u32x4*)(lds + (buf) * KBUF + skey * KP + sc * 16 + i_ * 128) = kreg[i_]; \
    if (BIAS) { if (tid < 16) *(ALAS f32x4*)(lds + OFF_B + (buf) * 256 + tid * 16) = breg; } } while (0)
#define ATT_STOREV(buf) do { \
    _Pragma("unroll") for (int i_ = 0; i_ < NVC; ++i_) *(ALAS u32x4*)(lds + OFF_V + (buf) * VBUF + (2 * i_ + (sc >> 2)) * 4096 + skey * 64 + (sc & 3) * 16) = vreg[i_]; } while (0)
    const int Tw = qmax >> 6;
    ATT_LOADK(0); ATT_LOADV(0);
    bf16x8 qr[NST];
#pragma unroll
    for (int st = 0; st < NST; ++st) qr[st] = *(const bf16x8*)(wsb + (size_t)(qoff + (unsigned)(qrow * qp * 2 + 16 * hi)) + 32 * st);
    f32x16 o[NDB];
#pragma unroll
    for (int db = 0; db < NDB; ++db)
#pragma unroll
        for (int r = 0; r < 16; ++r) o[db][r] = 0.f;
    float mrun = -INFINITY, lrun = 0.f;
    ATT_STOREK(0); ATT_STOREV(0);
    if constexpr (PIPE) { ATT_LOADK(1); ATT_STOREK(1); }
    __syncthreads();
    f32x16 pc0, pc1, pn0, pn1; u32x4 pw[4];
#define ATT_KRD(st) do { if constexpr ((st) < NST) { asm volatile("ds_read_b128 %0, %1 offset:%2" : "=v"(kf[(st) < NST ? (st) : 0][0]) : "v"(kaddr), "n"((st) * 32)); \
                                                     asm volatile("ds_read_b128 %0, %1 offset:%2" : "=v"(kf[(st) < NST ? (st) : 0][1]) : "v"(kaddr), "n"(32 * KP + (st) * 32)); } } while (0)
#define ATT_QKS(P0, P1, st) do { if constexpr ((st) < NST) { ATT_KRD((st) + PF); \
                        asm volatile("s_waitcnt lgkmcnt(%2)" : "+v"(kf[(st) < NST ? (st) : 0][0]), "+v"(kf[(st) < NST ? (st) : 0][1]) : "n"(2 * ((NST - 1 - (st)) < PF ? (NST - 1 - (st)) : PF))); \
                        P0 = __builtin_amdgcn_mfma_f32_32x32x16_bf16(kf[(st) < NST ? (st) : 0][0], qr[(st) < NST ? (st) : 0], P0, 0, 0, 0); \
                        P1 = __builtin_amdgcn_mfma_f32_32x32x16_bf16(kf[(st) < NST ? (st) : 0][1], qr[(st) < NST ? (st) : 0], P1, 0, 0, 0); } } while (0)
#define ATT_QK(P0, P1, kbuf) do { \
        const unsigned kaddr = (unsigned)(uintptr_t)(lds + (kbuf) * KBUF + r32 * KP + hi * 16); \
        if (BIAS) { const ALAS float* bb = (const ALAS float*)(lds + OFF_B + (kbuf) * 256); \
            _Pragma("unroll") for (int g = 0; g < 4; ++g) { const f32x4 b0 = *(const ALAS f32x4*)(bb + 8 * g + 4 * hi), b1 = *(const ALAS f32x4*)(bb + 32 + 8 * g + 4 * hi); \
                _Pragma("unroll") for (int e = 0; e < 4; ++e) { P0[4 * g + e] = b0[e]; P1[4 * g + e] = b1[e]; } } \
        } else { _Pragma("unroll") for (int r = 0; r < 16; ++r) { P0[r] = 0.f; P1[r] = 0.f; } } \
        { constexpr int PF = 3; bf16x8 kf[NST][2]; \
          ATT_KRD(0); ATT_KRD(1); ATT_KRD(2); \
          ATT_QKS(P0, P1, 0); ATT_QKS(P0, P1, 1); ATT_QKS(P0, P1, 2); ATT_QKS(P0, P1, 3); ATT_QKS(P0, P1, 4); ATT_QKS(P0, P1, 5); \
          ATT_QKS(P0, P1, 6); ATT_QKS(P0, P1, 7); ATT_QKS(P0, P1, 8); ATT_QKS(P0, P1, 9); ATT_QKS(P0, P1, 10); ATT_QKS(P0, P1, 11); } } while (0)
#define ATT_SOFTMAX(t) \
        if (64 * (t) + 63 > qmin) { \
            _Pragma("unroll") for (int r = 0; r < 16; ++r) { const int key = 64 * (t) + (r & 3) + 8 * (r >> 2) + 4 * hi; \
                if (key > qrow) pc0[r] = -INFINITY; if (key + 32 > qrow) pc1[r] = -INFINITY; } } \
        { float mx = fmaxf(pc0[0], pc1[0]); \
          _Pragma("unroll") for (int r = 1; r < 16; ++r) mx = fmaxf(mx, fmaxf(pc0[r], pc1[r])); \
          mx = fmaxf(mx, __shfl_xor(mx, 32)); \
          const float mn = fmaxf(mrun, mx), al = __builtin_amdgcn_exp2f(mrun - mn); \
          mrun = mn; \
          pc0 = pc0 - mn; pc1 = pc1 - mn; \
          _Pragma("unroll") for (int r = 0; r < 16; ++r) { pc0[r] = __builtin_amdgcn_exp2f(pc0[r]); pc1[r] = __builtin_amdgcn_exp2f(pc1[r]); } \
          { const f32x16 ps = pc0 + pc1; const float sum = ((ps[0] + ps[1]) + (ps[2] + ps[3])) + ((ps[4] + ps[5]) + (ps[6] + ps[7])) + ((ps[8] + ps[9]) + (ps[10] + ps[11])) + ((ps[12] + ps[13]) + (ps[14] + ps[15])); \
            lrun = lrun * al + sum; } \
          if (__any(al != 1.0f)) { _Pragma("unroll") for (int db = 0; db < NDB; ++db) o[db] = o[db] * al; } \
          _Pragma("unroll") for (int s = 0; s < 2; ++s) { \
              pw[s] = (u32x4){cvtpk(pc0[8 * s], pc0[8 * s + 1]), cvtpk(pc0[8 * s + 2], pc0[8 * s + 3]), cvtpk(pc0[8 * s + 4], pc0[8 * s + 5]), cvtpk(pc0[8 * s + 6], pc0[8 * s + 7])}; \
              pw[2 + s] = (u32x4){cvtpk(pc1[8 * s], pc1[8 * s + 1]), cvtpk(pc1[8 * s + 2], pc1[8 * s + 3]), cvtpk(pc1[8 * s + 4], pc1[8 * s + 5]), cvtpk(pc1[8 * s + 6], pc1[8 * s + 7])}; } }
#define ATT_VRD(j) do { if constexpr ((j) < NJ) { asm volatile("ds_read_b64_tr_b16 %0, %1 offset:%2" : "=v"(vlo[(j) < NJ ? (j) : 0]) : "v"(vaddr), "n"(((j) >> 2) * 4096 + ((j) & 3) * 1024)); \
                                                  asm volatile("ds_read_b64_tr_b16 %0, %1 offset:%2" : "=v"(vhi[(j) < NJ ? (j) : 0]) : "v"(vaddr), "n"(((j) >> 2) * 4096 + ((j) & 3) * 1024 + 512)); } } while (0)
#define ATT_PVS(j) do { if constexpr ((j) < NJ) { ATT_VRD((j) + PF2); \
                        asm volatile("s_waitcnt lgkmcnt(%2)" : "+v"(vlo[(j) < NJ ? (j) : 0]), "+v"(vhi[(j) < NJ ? (j) : 0]) : "n"(2 * ((NJ - 1 - (j)) < PF2 ? (NJ - 1 - (j)) : PF2))); \
                        { const s16x4 lo_ = vlo[(j) < NJ ? (j) : 0], hh_ = vhi[(j) < NJ ? (j) : 0]; const bf16x8 vf = (bf16x8){lo_[0], lo_[1], lo_[2], lo_[3], hh_[0], hh_[1], hh_[2], hh_[3]}; \
                          o[((j) < NJ ? (j) : 0) >> 2] = __builtin_amdgcn_mfma_f32_32x32x16_bf16(vf, __builtin_bit_cast(bf16x8, pw[(j) & 3]), o[((j) < NJ ? (j) : 0) >> 2], 0, 0, 0); } } } while (0)
#define ATT_PV(vbuf) do { \
        const unsigned vaddr = (unsigned)(uintptr_t)(lds + OFF_V + (vbuf) * VBUF + ((lane >> 4) & 1) * 32 + (lane & 3) * 8 + (4 * hi + ((lane & 15) >> 2)) * 64); \
        constexpr int NJ = NDB * 4, PF2 = 4; s16x4 vlo[NJ], vhi[NJ]; \
        ATT_VRD(0); ATT_VRD(1); ATT_VRD(2); ATT_VRD(3); \
        ATT_PVS(0); ATT_PVS(1); ATT_PVS(2); ATT_PVS(3); ATT_PVS(4); ATT_PVS(5); ATT_PVS(6); ATT_PVS(7); \
        ATT_PVS(8); ATT_PVS(9); ATT_PVS(10); ATT_PVS(11); ATT_PVS(12); ATT_PVS(13); ATT_PVS(14); ATT_PVS(15); } while (0)
    if constexpr (PIPE) {
    ATT_QK(pc0, pc1, 0);
    __syncthreads();
    for (int t = 0; t < NT; ++t) {
        if (t + 2 < NT) ATT_LOADK(t + 2);
        if (t + 1 < NT) ATT_LOADV(t + 1);
        if (t < Tw) {
            ATT_QK(pn0, pn1, (t + 1) & 1);
            ATT_SOFTMAX(t)
            ATT_PV(t & 1);
            pc0 = pn0; pc1 = pn1;
        } else if (t == Tw) {
            ATT_SOFTMAX(t)
            ATT_PV(t & 1);
        }
        if (t + 2 < NT) ATT_STOREK(t & 1);
        if (t + 1 < NT) ATT_STOREV((t + 1) & 1);
        __syncthreads();
    }
    } else {
    const bool g1 = wid >= 4; int v3 = 0, v3p = 2;
    for (int t = 0; t < NT; ++t) {
        if (t + 1 < NT) { ATT_LOADK(t + 1); ATT_LOADV(t + 1); }
        if (g1 && t >= 1 && t - 1 <= Tw) ATT_PV(v3p);
        if (t <= Tw) { ATT_QK(pc0, pc1, t & 1); ATT_SOFTMAX(t) }
        if (!g1 && t <= Tw) ATT_PV(v3);
        v3p = v3; v3 = (v3 == 2) ? 0 : v3 + 1;
        if (t + 1 < NT) { ATT_STOREK((t + 1) & 1); ATT_STOREV(v3); }
        __syncthreads();
    }
    if (g1 && NT - 1 <= Tw) ATT_PV(v3p);
    }
#undef ATT_KRD
#undef ATT_QKS
#undef ATT_QK
#undef ATT_SOFTMAX
#undef ATT_VRD
#undef ATT_PVS
#undef ATT_PV
    const float lt = lrun + __shfl_xor(lrun, 32), inv = 1.0f / lt;
    bf16_t* orow = (bf16_t*)(const_cast<unsigned char*>(wsb) + (size_t)(ooff + (unsigned)(qrow * op * 2 + 8 * hi)));
#pragma unroll
    for (int db = 0; db < NDB; ++db)
#pragma unroll
        for (int g = 0; g < 4; ++g) { u32x2 w; w.x = cvtpk(o[db][4 * g] * inv, o[db][4 * g + 1] * inv); w.y = cvtpk(o[db][4 * g + 2] * inv, o[db][4 * g + 3] * inv);
            *(u32x2*)(orow + 32 * db + 8 * g) = w; }
    __syncthreads();
#undef ATT_LOADK
#undef ATT_LOADV
#undef ATT_STOREK
#undef ATT_STOREV
}
}
#define LAS __attribute__((address_space(3)))
typedef unsigned short bf16;
typedef float f32x4 __attribute__((ext_vector_type(4)));
typedef float f32x2 __attribute__((ext_vector_type(2)));
typedef unsigned u32x4 __attribute__((ext_vector_type(4)));
typedef unsigned u32x2 __attribute__((ext_vector_type(2)));
constexpr int NB = 8, SEQ = 4096, DM = 1024, MT = NB * SEQ, DFF = 2816, PLED = 256, MH = MT / 2;
constexpr float ALPHA = 1.4142135623730951f, LN_EPS = 1e-5f, RMS_EPS = 1e-6f, LOG2E = 1.4426950408889634f;
constexpr size_t MiB = 1u << 20, QMiB = 1u << 18;
constexpr size_t WS_FIN = 0;
constexpr size_t WS_FOUT = 44 * MiB;
constexpr size_t WS_PG = 66 * MiB;
constexpr size_t WS_PP = 70 * MiB;
constexpr size_t WS_FOXIN = 71 * MiB;
constexpr size_t WS_FOXO = 71 * MiB + 26 * QMiB;
constexpr size_t WS_DQ = WS_FOXO + 2 * MiB;
constexpr size_t WS_UQ = WS_DQ + 1 * MiB;
constexpr size_t WS_MO = WS_UQ + 9 * QMiB;
constexpr size_t WS_KVD = WS_MO + 4 * MiB;
constexpr size_t WS_KVUP = WS_KVD + 1 * MiB;
constexpr size_t WS_RCOS = 90 * MiB, WS_RSIN = 90 * MiB + 2 * QMiB;
constexpr size_t WS_STATS = 91 * MiB;
constexpr size_t WS_CTL = 91 * MiB + 2 * QMiB;
constexpr size_t CTL_BYTES = 64 * 1024;
constexpr size_t WS_XB = 92 * MiB;
constexpr size_t WS_CKV = 156 * MiB;
constexpr size_t WS_KROPE = 172 * MiB;
constexpr size_t WS_CQB = 176 * MiB;
constexpr size_t WS_R = 200 * MiB;
constexpr size_t WS_H = WS_R;
constexpr size_t WS_KVDF = WS_R + 176 * MiB;
constexpr size_t WS_FQ = WS_R, WS_FK = WS_R + 64 * MiB, WS_FV = WS_R + 128 * MiB, WS_FLOG = WS_R + 192 * MiB, WS_FNB = WS_R + 194 * MiB, WS_FO = WS_R + 196 * MiB;
constexpr size_t WS_PBF = WS_R, WS_PPA = WS_R + 16 * MiB;
constexpr size_t WS_CQF = WS_R;
constexpr size_t WS_QM = WS_R, WS_KN = WS_R + 96 * MiB, WS_VV = WS_R + 160 * MiB, WS_OO = WS_R + 224 * MiB;
constexpr size_t WS_END = 512 * MiB;
static_assert(WS_KVUP + 2 * MiB <= WS_RCOS && WS_OO + 64 * MiB <= WS_END && WS_KVDF + 64 * MiB <= WS_END, "ws map");

constexpr int LDS_BYTES = 147456, LDS_BAR_OFF = 131072 + 1024;
constexpr int NPHASE = 30;

struct Args { const float* in[21]; float* out; unsigned char* ws; int lo, hi, G, pad; };
static_assert(sizeof(Args) == 200, "Args layout");
__device__ const double ROPE_INV[32] = {1.0, 0.7498942093324559, 0.5623413251903491, 0.4216965034285822, 0.31622776601683794, 0.23713737056616552, 0.1778279410038923, 0.1333521432163324, 0.1, 0.07498942093324558, 0.05623413251903491, 0.042169650342858224, 0.03162277660168379, 0.023713737056616554, 0.01778279410038923, 0.01333521432163324, 0.01, 0.007498942093324558, 0.005623413251903491, 0.004216965034285823, 0.0031622776601683794, 0.0023713737056616554, 0.0017782794100389228, 0.001333521432163324, 0.001, 0.0007498942093324559, 0.0005623413251903491, 0.00042169650342858224, 0.00031622776601683794, 0.00023713737056616554, 0.00017782794100389227, 0.0001333521432163324};

__device__ __forceinline__ unsigned f2bf(float f) { unsigned u = __builtin_bit_cast(unsigned, f); return (u + 0x7fffu + ((u >> 16) & 1u)) >> 16; }
__device__ __forceinline__ unsigned pk2(float lo, float hi) { return f2bf(lo) | (f2bf(hi) << 16); }
__device__ __forceinline__ float wave_sum(float v) {
#pragma unroll
    for (int o = 1; o < 64; o <<= 1) v += __shfl_xor(v, o);
    return v;
}
struct Ctx { int tid, lane, wave, vcu, G, gw, NGW, bx; LAS unsigned char* lds; };

__device__ __forceinline__ int dst_row(int n, int mode) {
    if (mode == 1) { const int up = n >= DFF ? 1 : 0, j = n - up * DFF; return (j >> 7) * 256 + up * 128 + (j & 127); }
    if (mode == 2) { const int h = n / 192, w = n % 192; if (w < 128) return n; const int i = w - 128; return h * 192 + 128 + 2 * (i & 31) + (i >> 5); }
    return n;
}
__device__ __forceinline__ void transpose_mat(const Ctx& C, const float* W, int K, int N, bf16* WT, int mode) {
    LAS float* scr = (LAS float*)(C.lds + C.wave * 16384);
    const int nblk = (N + 31) / 32, nitems = (K / 64) * nblk, lane = C.lane;
    for (int it = C.gw; it < nitems; it += C.NGW) {
        const int kb = it / nblk, nb = it % nblk, k0 = 64 * kb, n0 = 32 * nb;
        const int nn = n0 + (lane & 31);
#pragma unroll 8
        for (int i = 0; i < 32; ++i) { const int kk = 2 * i + (lane >> 5); scr[kk * 33 + (lane & 31)] = nn < N ? W[(size_t)(k0 + kk) * N + nn] : 0.f; }
        asm volatile("s_waitcnt lgkmcnt(0)" ::: "memory");
        const int c = lane & 7;
#pragma unroll
        for (int j = 0; j < 4; ++j) { const int nl = (lane >> 3) + 8 * j, n = n0 + nl; const LAS float* s = scr + (8 * c) * 33 + nl;
            u32x4 o; o.x = pk2(s[0 * 33], s[1 * 33]); o.y = pk2(s[2 * 33], s[3 * 33]); o.z = pk2(s[4 * 33], s[5 * 33]); o.w = pk2(s[6 * 33], s[7 * 33]);
            if (n < N) *(u32x4*)(WT + (size_t)dst_row(n, mode) * K + k0 + 8 * c) = o; }
        asm volatile("s_waitcnt lgkmcnt(0)" ::: "memory");
    }
}
__device__ __forceinline__ void zero_rows(const Ctx& C, bf16* WT, int K, int r0, int r1) {
    const size_t n16 = (size_t)(r1 - r0) * K / 8; u32x4* p = (u32x4*)(WT + (size_t)r0 * K);
    for (size_t i = (size_t)C.gw * 64 + C.lane; i < n16; i += (size_t)C.NGW * 64) p[i] = (u32x4){0u, 0u, 0u, 0u};
}
__device__ __forceinline__ void cvt_rows(const Ctx& C, const float* src, bf16* dst, size_t n) {
    const size_t n8 = n / 8;
    for (size_t i = (size_t)C.gw * 64 + C.lane; i < n8; i += (size_t)C.NGW * 64) { const f32x4 a = *(const f32x4*)(src + 8 * i), b = *(const f32x4*)(src + 8 * i + 4);
        *(u32x4*)(dst + 8 * i) = (u32x4){pk2(a.x, a.y), pk2(a.z, a.w), pk2(b.x, b.y), pk2(b.z, b.w)}; }
}
__device__ __forceinline__ void rope_tables(const Ctx& C, float* rc, float* rs) {
    for (int idx = C.gw * 64 + C.lane; idx < SEQ * 32; idx += C.NGW * 64) {
        const int pos = idx >> 5, i = idx & 31; const double ang = (double)pos * ROPE_INV[i];
        const double k = __builtin_rint(ang * 0.15915494309189535); double r = __builtin_fma(-k, 6.283185307179586, ang); r = __builtin_fma(-k, 2.4492935982947064e-16, r);
        const double r2 = r * r; double sn = 0.0, cs = 0.0;
#pragma unroll
        for (int n = 16; n >= 1; --n) { sn = (1.0 - sn) * (r2 * (1.0 / (double)((2 * n) * (2 * n + 1)))); cs = (1.0 - cs) * (r2 * (1.0 / (double)((2 * n - 1) * (2 * n)))); }
        rs[idx] = (float)(r * (1.0 - sn)); rc[idx] = (float)(1.0 - cs);
    }
}
__device__ __forceinline__ void ln_phase(const Ctx& C, float* Y, const float* g, const float* b, bf16* XB, float* stats, bool final_) {
    const f32x4* g4 = (const f32x4*)g + C.lane; const f32x4* b4 = (const f32x4*)b + C.lane;
    for (int m = C.gw; m < MT; m += C.NGW) {
        f32x4* yr = (f32x4*)(Y + (size_t)m * DM) + C.lane;
        f32x4 v[4]; float s = 0.f;
#pragma unroll
        for (int j = 0; j < 4; ++j) { v[j] = yr[64 * j]; s += (v[j].x + v[j].y) + (v[j].z + v[j].w); }
        const float mean = wave_sum(s) * (1.f / DM); float s2 = 0.f;
#pragma unroll
        for (int j = 0; j < 4; ++j) { const f32x4 d = v[j] - mean; s2 += (d.x * d.x + d.y * d.y) + (d.z * d.z + d.w * d.w); }
        const float rstd = 1.f / sqrtf(wave_sum(s2) * (1.f / DM) + LN_EPS);
        if (final_) {
#pragma unroll
            for (int j = 0; j < 4; ++j) yr[64 * j] = (v[j] - mean) * rstd * g4[64 * j] + b4[64 * j];
        } else {
            if (C.lane == 0) *(f32x2*)(stats + 2 * (size_t)m) = (f32x2){mean, rstd};
            u32x2* o8 = (u32x2*)(XB + (size_t)m * DM) + C.lane;
#pragma unroll
            for (int j = 0; j < 4; ++j) { const f32x4 x = (v[j] - mean) * rstd * g4[64 * j] + b4[64 * j]; o8[64 * j] = (u32x2){pk2(x.x, x.y), pk2(x.z, x.w)}; }
        }
    }
}
__device__ __forceinline__ float logsig(float z) { return fminf(z, 0.f) - log1pf(expf(-fabsf(z))); }
__device__ __forceinline__ void scan_phase(const Ctx& C, const float* __restrict__ flog, const float* __restrict__ bfv, float* __restrict__ nbo) {
    if (C.wave != 0) return;
    for (int bh = C.vcu; bh < NB * 16; bh += C.G) {
        const int bb = bh >> 4, h = bh & 15; const float bias = bfv[h];
        const float* src = flog + ((size_t)bb * SEQ + C.lane) * 16 + h;
        float* dst = nbo + (size_t)bh * SEQ + C.lane;
        double carry = 0.0;
        for (int c0 = 0; c0 < 64; c0 += 16) {
            float v[16];
#pragma unroll
            for (int i = 0; i < 16; ++i) v[i] = src[(size_t)(c0 + i) * 64 * 16];
#pragma unroll
            for (int i = 0; i < 16; ++i) {
                double x = (double)logsig(v[i] + bias);
#pragma unroll
                for (int o = 1; o < 64; o <<= 1) { const double t = __shfl_up(x, o); if (C.lane >= o) x += t; }
                x += carry;
                dst[(c0 + i) * 64] = (float)(-x * 1.4426950408889634);
                carry = __shfl(x, 63);
            }
        }
    }
}
__device__ __forceinline__ void kvpost_phase(const Ctx& C, const float* kvd, const float* kvn, const float* rc, const float* rs, bf16* ckv, bf16* krope) {
    const f32x4 gn = *((const f32x4*)kvn + C.lane);
    for (int m = C.gw; m < MT; m += C.NGW) {
        const float* row = kvd + (size_t)m * 512;
        const f32x4 v = *((const f32x4*)row + C.lane);
        const float ss = wave_sum((v.x * v.x + v.y * v.y) + (v.z * v.z + v.w * v.w));
        const float rr = 1.f / sqrtf(ss * (1.f / 256.f) + RMS_EPS);
        *((u32x2*)(ckv + (size_t)m * 256) + C.lane) = (u32x2){pk2(v.x * rr * gn.x, v.y * rr * gn.y), pk2(v.z * rr * gn.z, v.w * rr * gn.w)};
        if (C.lane < 32) { const int pos = m & (SEQ - 1); const float x1 = row[256 + C.lane], x2 = row[288 + C.lane], c = rc[pos * 32 + C.lane], s = rs[pos * 32 + C.lane];
            *((unsigned*)(krope + (size_t)m * 64) + C.lane) = pk2(x1 * c - x2 * s, x2 * c + x1 * s); }
    }
}
__device__ __forceinline__ void cqpost_phase(const Ctx& C, const float* cq, const float* qn, bf16* cqb) {
    const f32x2 g0 = *((const f32x2*)qn + C.lane), g1 = *((const f32x2*)qn + 64 + C.lane), g2 = *((const f32x2*)qn + 128 + C.lane);
    for (int m = C.gw; m < MT; m += C.NGW) {
        const f32x2* row = (const f32x2*)(cq + (size_t)m * 512) + C.lane;
        const f32x2 a = row[0], b = row[64], c = row[128];
        const float ss = wave_sum((a.x * a.x + a.y * a.y) + (b.x * b.x + b.y * b.y) + (c.x * c.x + c.y * c.y));
        const float rr = 1.f / sqrtf(ss * (1.f / 384.f) + RMS_EPS);
        unsigned* o = (unsigned*)(cqb + (size_t)m * 384) + C.lane;
        o[0] = pk2(a.x * rr * g0.x, a.y * rr * g0.y); o[64] = pk2(b.x * rr * g1.x, b.y * rr * g1.y); o[128] = pk2(c.x * rr * g2.x, c.y * rr * g2.y);
    }
}
#define XB_TMO      128
#define XB_XCNT(j)  (256  + 64 * (j))
#define XB_XSUB(j)  (1280 + 64 * (j))
#define XB_XGEN(j)  (2304 + 64 * (j))
#define XB_TOP      3328
#define XB_TOPGEN   3392
#define XCD_BAR_WORDS 3456
#define XB_SPIN_CAP (1u << 18)

__device__ __forceinline__ unsigned xb_ld(unsigned* p)              { return __hip_atomic_load(p, __ATOMIC_RELAXED, __HIP_MEMORY_SCOPE_AGENT); }
__device__ __forceinline__ unsigned xb_add(unsigned* p, unsigned v) { return __hip_atomic_fetch_add(p, v, __ATOMIC_RELAXED, __HIP_MEMORY_SCOPE_AGENT); }
__device__ __forceinline__ unsigned xb_xcc_id() { return (unsigned)__builtin_amdgcn_s_getreg((3 << 11) | 20) & 0xFu; }
#define XB_SPIN(cond, bar) do { unsigned _sp = 0; while (cond) { __builtin_amdgcn_s_sleep(1); \
    if ((++_sp & 255u) == 0u) { if (xb_ld(&(bar)[XB_TMO])) break; if (_sp > XB_SPIN_CAP) { atomicAdd(&(bar)[XB_TMO], 1u); break; } } } } while (0)

struct XcdBarrier {
    unsigned* bar; unsigned x;
    volatile LAS unsigned* st;
};

__device__ __forceinline__ XcdBarrier xcd_barrier_post(unsigned* bar, volatile LAS unsigned* st) {
    XcdBarrier b; b.bar = bar; b.x = xb_xcc_id(); b.st = st;
    if (threadIdx.x == 0) (void)xb_add(&bar[XB_XCNT(b.x)], 1u);
    return b;
}
__device__ __forceinline__ void xcd_barrier_complete(unsigned* bar, unsigned x, unsigned& nloc, unsigned& nx) {
    const unsigned G = gridDim.x * gridDim.y * gridDim.z;
    unsigned sum, cnt, mine, sp = 0u;
    for (;;) {
        sum = 0u; cnt = 0u; mine = 0u;
#pragma unroll
        for (unsigned j = 0; j < 16; ++j) { const unsigned c = xb_ld(&bar[XB_XCNT(j)]); sum += c; cnt += (c > 0u) ? 1u : 0u; mine = (j == x) ? c : mine; }
        if (sum == G) break;
        __builtin_amdgcn_s_sleep(1);
        if ((++sp & 255u) == 0u) { if (xb_ld(&bar[XB_TMO])) break; if (sp > XB_SPIN_CAP) { atomicAdd(&bar[XB_TMO], 1u); break; } }
    }
    nloc = mine > 0u ? mine : 1u; nx = cnt > 0u ? cnt : 1u;
}

__device__ __forceinline__ void xcd_barrier(const XcdBarrier& b) {
    asm volatile("s_waitcnt vmcnt(0)" ::: "memory");
    __syncthreads();
    if (threadIdx.x == 0) {
        unsigned* bar = b.bar;
        __builtin_amdgcn_s_waitcnt(0);
        unsigned nloc = b.st[0], nx = b.st[1];
        if (nloc == 0u) { xcd_barrier_complete(bar, b.x, nloc, nx); b.st[0] = nloc; b.st[1] = nx; }
        const unsigned old = xb_add(&bar[XB_XSUB(b.x)], 1u);
        const unsigned gen = old / nloc;
        if (old + 1u == (gen + 1u) * nloc) {
            __builtin_amdgcn_fence(__ATOMIC_RELEASE, "agent");
            asm volatile("s_waitcnt vmcnt(0)" ::: "memory");
            const unsigned og = xb_add(&bar[XB_TOP], 1u);
            const unsigned tg = og / nx;
            if (og + 1u == (tg + 1u) * nx) xb_add(&bar[XB_TOPGEN], 1u);
            else XB_SPIN(xb_ld(&bar[XB_TOPGEN]) == tg, bar);
            __builtin_amdgcn_fence(__ATOMIC_ACQUIRE, "agent");
            xb_add(&bar[XB_XGEN(b.x)], 1u);
            asm volatile("s_waitcnt vmcnt(0)" ::: "memory");
        } else {
            XB_SPIN(xb_ld(&bar[XB_XGEN(b.x)]) == gen, bar);
            __builtin_amdgcn_fence(__ATOMIC_ACQUIRE, "agent");
            asm volatile("s_waitcnt vmcnt(0)" ::: "memory");
        }
    }
    __syncthreads();
}

template <int OFF_> __device__ __forceinline__ const float* kargb() {
#if defined(__HIP_DEVICE_COMPILE__)
    const auto kp = __builtin_amdgcn_kernarg_segment_ptr(); const float* r;
    asm volatile("s_load_dwordx2 %0, %1, %2\n\ts_waitcnt lgkmcnt(0)" : "=s"(r) : "s"(kp), "i"(OFF_) : "memory"); return r;
#else
    return nullptr;
#endif
}
template <int OFF_> __device__ __forceinline__ int kargi() {
#if defined(__HIP_DEVICE_COMPILE__)
    const auto kp = __builtin_amdgcn_kernarg_segment_ptr(); int r;
    asm volatile("s_load_dword %0, %1, %2\n\ts_waitcnt lgkmcnt(0)" : "=s"(r) : "s"(kp), "i"(OFF_) : "memory"); return r;
#else
    return 0;
#endif
}
template <class Epi> __device__ __forceinline__ void run_gemm(LAS unsigned char* lds, const bf16* A, const bf16* Bt, int M, int N, int K, int G, int bx, const Epi& E) {
    asm volatile("" : "+s"(K));
    pg8::Gemm g{A, Bt, M, N, K}; pg8::StaticOrder S; S.init(M, N, G, bx);
    pg8::gemm_phase<Epi, pg8::StaticOrder, true, true>(lds, g, S, E);
}

__global__ void __launch_bounds__(512, 2) fwd(Args a) {
    __shared__ __attribute__((aligned(16))) unsigned char lds_raw[LDS_BYTES];
    LAS unsigned char* lds = (LAS unsigned char*)lds_raw;
    const int lo = a.lo, hi = a.hi;
    if (threadIdx.x < 4) ((LAS unsigned*)(lds + LDS_BAR_OFF))[threadIdx.x] = 0u;
    __syncthreads();
    if (hi - lo > 1) (void)xcd_barrier_post((unsigned*)(a.ws + WS_CTL), (volatile LAS unsigned*)(lds + LDS_BAR_OFF));
#define PH_BEGIN Ctx C; { int bx_ = blockIdx.x; asm volatile("" : "+s"(bx_)); C.tid = threadIdx.x; asm volatile("" : "+v"(C.tid)); C.lane = C.tid & 63; C.wave = __builtin_amdgcn_readfirstlane(C.tid >> 6); C.G = kargi<192>(); \
        C.vcu = (C.G % 8 == 0) ? (bx_ % 8) * (C.G / 8) + bx_ / 8 : bx_; C.gw = C.vcu * 8 + C.wave; C.NGW = C.G * 8; C.lds = lds; C.bx = bx_; } \
        unsigned char* ws = (unsigned char*)kargb<176>(); float* Y = (float*)kargb<168>()
#define KARG(k) kargb<(k) * 8>()
#define x_in KARG(0)
#define p_in KARG(1)
#define ln_g KARG(6)
#define ln_b KARG(7)
#define XB ((bf16*)(ws + WS_XB))
#define H ((bf16*)(ws + WS_H))
#define STATS ((float*)(ws + WS_STATS))
#define RC ((float*)(ws + WS_RCOS))
#define RS ((float*)(ws + WS_RSIN))
#define WFIN(l, f) ((bf16*)(ws + WS_FIN + (size_t)((l) * 2 + (f)) * 11 * MiB))
#define WFOUT(l, f) ((bf16*)(ws + WS_FOUT + (size_t)((l) * 2 + (f)) * 22 * QMiB))
#define WPG(l) ((bf16*)(ws + WS_PG + (size_t)(l) * 2 * MiB))
#define WPP(l) ((bf16*)(ws + WS_PP + (size_t)(l) * 2 * QMiB))
#define LNG(l, k) (ln_g + ((l) * 4 + (k)) * DM)
#define LNB(l, k) (ln_b + ((l) * 4 + (k)) * DM)
#ifndef ATT_REPEAT
#define ATT_REPEAT 1
#endif
#ifndef PHASE_MASK
#define PHASE_MASK 0xffffffffull
#endif
#define IN(k) ((((unsigned long long)PHASE_MASK >> (k)) & 1ull) && lo <= (k) && (k) < hi)
#define SEAM(k) do { if ((k) + 1 < hi) { if ((k) == 0) cg::this_grid().sync(); else { XcdBarrier b_; b_.bar = (unsigned*)(ws + WS_CTL); b_.x = xb_xcc_id(); b_.st = (volatile LAS unsigned*)(lds + LDS_BAR_OFF); xcd_barrier(b_); } } } while (0)

    if (IN(0)) { PH_BEGIN;
        for (int l = 0; l < 2; ++l) {
            transpose_mat(C, KARG(2) + (size_t)l * DM * 2 * DFF, DM, 2 * DFF, WFIN(l, 0), 1);
            transpose_mat(C, KARG(4) + (size_t)l * DM * 2 * DFF, DM, 2 * DFF, WFIN(l, 1), 1);
            transpose_mat(C, KARG(3) + (size_t)l * DFF * DM, DFF, DM, WFOUT(l, 0), 0);
            transpose_mat(C, KARG(5) + (size_t)l * DFF * DM, DFF, DM, WFOUT(l, 1), 0);
            transpose_mat(C, KARG(8) + (size_t)l * DM * DM, DM, DM, WPG(l), 0);
            transpose_mat(C, KARG(10) + (size_t)l * PLED * DM, PLED, DM, WPP(l), 0);
        }
        transpose_mat(C, KARG(11), DM, 3088, (bf16*)(ws + WS_FOXIN), 0);
        zero_rows(C, (bf16*)(ws + WS_FOXIN), DM, 3088, 3328);
        transpose_mat(C, KARG(13), DM, DM, (bf16*)(ws + WS_FOXO), 0);
        transpose_mat(C, KARG(14), DM, 384, (bf16*)(ws + WS_DQ), 0);
        zero_rows(C, (bf16*)(ws + WS_DQ), DM, 384, 512);
        transpose_mat(C, KARG(16), 384, 3072, (bf16*)(ws + WS_UQ), 2);
        transpose_mat(C, KARG(17), 2048, DM, (bf16*)(ws + WS_MO), 0);
        transpose_mat(C, KARG(18), DM, 320, (bf16*)(ws + WS_KVD), 0);
        zero_rows(C, (bf16*)(ws + WS_KVD), DM, 320, 512);
        transpose_mat(C, KARG(20), 256, 4096, (bf16*)(ws + WS_KVUP), 0);
        cvt_rows(C, x_in, XB, (size_t)MT * DM);
        rope_tables(C, RC, RS);
        __syncthreads();
        SEAM(0);
    }
#pragma unroll
    for (int l = 0; l < 2; ++l) {
        const int P = 1 + (l == 0 ? 0 : 13);
        if (l == 0) {
            if (IN(1)) { PH_BEGIN; run_gemm(lds, XB, WFIN(0, 0), MT, 2 * DFF, DM, C.G, C.bx, pg8::EpiSwiGLU{H, DFF}); SEAM(1); }
            if (IN(2)) { PH_BEGIN; run_gemm(lds, H, WFOUT(0, 0), MT, DM, DFF, C.G, C.bx, pg8::EpiRes{Y, x_in, STATS, nullptr, nullptr, ALPHA, 0.5f, 0, 0}); SEAM(2); }
            if (IN(3)) { PH_BEGIN; ln_phase(C, Y, LNG(0, 0), LNB(0, 0), XB, STATS, false); SEAM(3); }
#define FQ ((bf16*)(ws + WS_FQ))
#define FK ((bf16*)(ws + WS_FK))
#define FV ((bf16*)(ws + WS_FV))
#define FLOG ((float*)(ws + WS_FLOG))
#define FNB ((float*)(ws + WS_FNB))
            if (IN(4)) { PH_BEGIN; run_gemm(lds, XB, (bf16*)(ws + WS_FOXIN), MT, 3328, DM, C.G, C.bx, pg8::EpiFox{FQ, FK, FV, FLOG, 0.125f * LOG2E}); SEAM(4); }
            if (IN(5)) { PH_BEGIN; scan_phase(C, FLOG, KARG(12), FNB); SEAM(5); }
            if (IN(6)) { PH_BEGIN;
                for (int rep_ = 0; rep_ < ATT_REPEAT; ++rep_)
                for (int v = C.vcu; v < 256; v += C.G) { const int bh = v >> 1, s = v & 1, bb = bh >> 4, h = bh & 15; const unsigned base = (unsigned)(((size_t)bb * SEQ * DM + h * 64) * 2);
                    for (int j = 0; j < 8; ++j) { const int gi = j >> 1, qb = (j & 1) ? 4 * gi + 3 - s : 4 * gi + s;
                        att::attn_unit<64, 64, 64, true, false>(lds, ws, (unsigned)WS_FQ + base, DM, (unsigned)WS_FK + base, DM, 0u, 0, (unsigned)WS_FV + base, DM, (unsigned)WS_FO + base, DM, FNB + (size_t)bh * SEQ, qb * 256); } }
                SEAM(6);
            }
            if (IN(7)) { PH_BEGIN; run_gemm(lds, (bf16*)(ws + WS_FO), (bf16*)(ws + WS_FOXO), MT, DM, DM, C.G, C.bx, pg8::EpiRes{Y, nullptr, STATS, LNG(0, 0), LNB(0, 0), ALPHA, 1.0f, 1, 0}); SEAM(7); }
            if (IN(8)) { PH_BEGIN; ln_phase(C, Y, LNG(0, 1), LNB(0, 1), XB, STATS, false); SEAM(8); }
        } else {
#define CKV ((bf16*)(ws + WS_CKV))
#define KROPE ((bf16*)(ws + WS_KROPE))
#define CQB ((bf16*)(ws + WS_CQB))
#define KVDF ((float*)(ws + WS_KVDF))
#define CQF ((float*)(ws + WS_CQF))
#define QM ((bf16*)(ws + WS_QM))
#define KN ((bf16*)(ws + WS_KN))
#define VV ((bf16*)(ws + WS_VV))
#define OO ((bf16*)(ws + WS_OO))
            const float qs = 0.07216878364870322f * LOG2E;
            if (IN(14)) { PH_BEGIN; run_gemm(lds, XB, (bf16*)(ws + WS_KVD), MT, 512, DM, C.G, C.bx, pg8::EpiF32{KVDF, 512});
                          run_gemm(lds, XB, WFIN(1, 0), MT, 2 * DFF, DM, C.G, C.bx, pg8::EpiSwiGLU{H, DFF}); SEAM(14); }
            if (IN(15)) { PH_BEGIN; kvpost_phase(C, KVDF, KARG(19), RC, RS, CKV, KROPE);
                          run_gemm(lds, H, WFOUT(1, 0), MT, DM, DFF, C.G, C.bx, pg8::EpiRes{Y, nullptr, STATS, LNG(0, 3), LNB(0, 3), ALPHA, 0.5f, 1, 0}); SEAM(15); }
            if (IN(16)) { PH_BEGIN; ln_phase(C, Y, LNG(1, 0), LNB(1, 0), XB, STATS, false); SEAM(16); }
            if (IN(17)) { PH_BEGIN; run_gemm(lds, XB, (bf16*)(ws + WS_DQ), MT, 512, DM, C.G, C.bx, pg8::EpiF32{CQF, 512}); SEAM(17); }
            if (IN(18)) { PH_BEGIN; cqpost_phase(C, CQF, KARG(15), CQB); SEAM(18); }
#pragma unroll
            for (int hf = 0; hf < 2; ++hf) {
                const int pg = hf == 0 ? 19 : 21, pa = hf == 0 ? 20 : 22;
                if (IN(pg)) { PH_BEGIN;
                    if (hf == 1) run_gemm(lds, OO, (bf16*)(ws + WS_MO), MH, DM, 2048, C.G, C.bx, pg8::EpiRes{Y, nullptr, STATS, LNG(1, 0), LNB(1, 0), ALPHA, 1.0f, 1, 0});
                    run_gemm(lds, CQB + (size_t)hf * MH * 384, (bf16*)(ws + WS_UQ), MH, 3072, 384, C.G, C.bx, pg8::EpiQ{QM, RC, RS, qs});
                    run_gemm(lds, CKV + (size_t)hf * MH * 256, (bf16*)(ws + WS_KVUP), MH, 4096, 256, C.G, C.bx, pg8::EpiKV{KN, VV});
                    SEAM(pg);
                }
                if (IN(pa)) { PH_BEGIN;
                    for (int rep_ = 0; rep_ < ATT_REPEAT; ++rep_)
                    for (int v = C.vcu; v < 256; v += C.G) { const int bh = v >> 2, s = v & 3, bl = bh >> 4, h = bh & 15; const unsigned lrow = (unsigned)bl * SEQ, grow = (unsigned)(4 * hf + bl) * SEQ;
                        for (int j = 0; j < 4; ++j) { const int gi = j >> 1, qb = (j & 1) ? 8 * gi + 7 - s : 8 * gi + s;
                            att::attn_unit<192, 128, 128, false, false>(lds, ws, (unsigned)WS_QM + (lrow * 3072 + h * 192) * 2, 3072, (unsigned)WS_KN + (lrow * 2048 + h * 128) * 2, 2048, (unsigned)WS_KROPE + grow * 64 * 2, 64,
                                                                 (unsigned)WS_VV + (lrow * 2048 + h * 128) * 2, 2048, (unsigned)WS_OO + (lrow * 2048 + h * 128) * 2, 2048, nullptr, qb * 256); } }
                    SEAM(pa);
                }
            }
            if (IN(23)) { PH_BEGIN; run_gemm(lds, OO, (bf16*)(ws + WS_MO), MH, DM, 2048, C.G, C.bx, pg8::EpiRes{Y, nullptr, STATS, LNG(1, 0), LNB(1, 0), ALPHA, 1.0f, 1, MH}); SEAM(23); }
            if (IN(24)) { PH_BEGIN; ln_phase(C, Y, LNG(1, 1), LNB(1, 1), XB, STATS, false); SEAM(24); }
        }
        const int Q0 = l == 0 ? 9 : 25;
        if (IN(Q0)) { PH_BEGIN; run_gemm(lds, XB, WFIN(l, 1), MT, 2 * DFF, DM, C.G, C.bx, pg8::EpiSwiGLU{H, DFF}); SEAM(Q0); }
        if (IN(Q0 + 1)) { PH_BEGIN; run_gemm(lds, H, WFOUT(l, 1), MT, DM, DFF, C.G, C.bx, pg8::EpiRes{Y, nullptr, STATS, LNG(l, 1), LNB(l, 1), ALPHA, 0.5f, 1, 0}); SEAM(Q0 + 1); }
        if (IN(Q0 + 2)) { PH_BEGIN; ln_phase(C, Y, LNG(l, 2), LNB(l, 2), XB, STATS, false); cvt_rows(C, p_in + (size_t)l * MT * PLED, (bf16*)(ws + WS_PBF), (size_t)MT * PLED); SEAM(Q0 + 2); }
        if (IN(Q0 + 3)) { PH_BEGIN; bf16* PPA = (bf16*)(ws + WS_PPA);
            run_gemm(lds, (bf16*)(ws + WS_PBF), WPP(l), MT, DM, PLED, C.G, C.bx, pg8::EpiBf16P{PPA, DM});
            run_gemm(lds, XB, WPG(l), MT, DM, DM, C.G, C.bx, pg8::EpiPle{Y, STATS, LNG(l, 2), LNB(l, 2), KARG(9) + l * DM, PPA, ALPHA}); SEAM(Q0 + 3); }
        if (IN(Q0 + 4)) { PH_BEGIN; ln_phase(C, Y, LNG(l, 3), LNB(l, 3), XB, STATS, l == 1); SEAM(Q0 + 4); }
        (void)P;
    }
}

extern "C" void kernel_launch(void* const* d_in, const int* in_sizes, int n_in, void* d_out, int out_size, void* d_ws, size_t ws_size, hipStream_t stream) {
    static int grid = 0;
    if (grid == 0) {
        if (n_in != 21 || out_size != MT * DM || ws_size < WS_END) { fprintf(stderr, "kernel_launch: unexpected shapes: n_in %d out %d ws %zu (need %zu)\n", n_in, out_size, ws_size, (size_t)WS_END); grid = -1; return; }
        int dev = 0, cus = 0;
        if (hipGetDevice(&dev) != hipSuccess || hipDeviceGetAttribute(&cus, hipDeviceAttributeMultiprocessorCount, dev) != hipSuccess) { grid = -1; return; }
        int per_cu = 0;
        if (hipOccupancyMaxActiveBlocksPerMultiprocessor(&per_cu, (const void*)fwd, 512, 0) != hipSuccess || per_cu < 1) fprintf(stderr, "kernel_launch: occupancy query says %d\n", per_cu);
        (void)hipGetLastError();
        grid = cus;
    }
    if (grid < 0) return;
    if (hipMemsetAsync((char*)d_ws + WS_CTL, 0, CTL_BYTES, stream) != hipSuccess) { fprintf(stderr, "kernel_launch: memset failed\n"); return; }
    Args a{};
    for (int i = 0; i < 21; ++i) a.in[i] = (const float*)d_in[i];
    a.out = (float*)d_out; a.ws = (unsigned char*)d_ws; a.G = grid;
#if MULTI_LAUNCH
    for (int ph = 0; ph < NPHASE; ++ph) { a.lo = ph; a.hi = ph + 1; hipLaunchKernelGGL(fwd, dim3(grid), dim3(512), 0, stream, a); }
#else
    a.lo = 0; a.hi = NPHASE;
    void* args[] = {&a};
    hipError_t e = hipLaunchCooperativeKernel((const void*)fwd, dim3(grid), dim3(512), args, 0, stream);
    if (e != hipSuccess) fprintf(stderr, "cooperative launch failed: %s (grid %d)\n", hipGetErrorString(e), grid);
#endif
}
```
